# Optimizing an MI355X kernel written in HIP

```python
import math
import jax, jax.numpy as jnp
from jax import lax
import numpy as np

D_MODEL = 2048
BATCH = 8
SEQ = 2048
DEPTH = 2

CHUNK = 64
EPS = 1e-6
RET_HEADS = 8
RET_QK_DIM = D_MODEL // RET_HEADS
RET_V_DIM = 2 * RET_QK_DIM
RET_HV = RET_HEADS * RET_V_DIM
ROPE_BASE = 10000.0
ATT_HEADS = 16
ATT_HEAD_DIM = D_MODEL // ATT_HEADS
LEFT_CHUNKS = 8
BAND = (LEFT_CHUNKS + 1) * CHUNK
REL_CLIP = 128
NEG_INF = -1e30
D_FF = 5632
N_EXPERTS = 8
TOP_K = 2
D_FF_EXPERT = 7168
N_A = (DEPTH + 1) // 2
N_B = DEPTH // 2

kernel_name = "hybrid_retention_chunkattn_moe_trunk"


def rmsnorm(x, g):
    xf = x.astype(jnp.float32)
    y = xf * lax.rsqrt(jnp.mean(xf * xf, axis=-1, keepdims=True) + EPS)
    return (y * g.astype(jnp.float32)).astype(x.dtype)


def rotary(x, pos):
    dh = x.shape[-1]
    inv_freq = ROPE_BASE ** (-jnp.arange(0, dh, 2, dtype=jnp.float32) / dh)
    ang = pos[:, None] * inv_freq[None, :]
    cos = jnp.cos(ang)[None, :, None, :]
    sin = jnp.sin(ang)[None, :, None, :]
    xf = x.astype(jnp.float32)
    x1, x2 = jnp.split(xf, 2, axis=-1)
    out = jnp.concatenate([x1 * cos - x2 * sin, x1 * sin + x2 * cos], axis=-1)
    return out.astype(x.dtype)


def retention(h, w_in, w_out):
    B, S, _ = h.shape
    NC = S // CHUNK
    proj = h @ w_in
    q, k, v, g = jnp.split(proj, [D_MODEL, 2 * D_MODEL, 2 * D_MODEL + RET_HV], axis=-1)
    q = q.reshape(B, S, RET_HEADS, RET_QK_DIM)
    k = k.reshape(B, S, RET_HEADS, RET_QK_DIM)
    v = v.reshape(B, S, RET_HEADS, RET_V_DIM)
    pos = jnp.arange(S, dtype=jnp.float32)
    q = rotary(q, pos)
    k = rotary(k, pos) * (RET_QK_DIM ** -0.5)

    gamma = 1.0 - jnp.exp2(-5.0 - jnp.arange(RET_HEADS, dtype=jnp.float32))
    log_g = jnp.log(gamma)
    r = jnp.arange(CHUNK, dtype=jnp.float32)
    intra_decay = jnp.exp(log_g[:, None, None] * jnp.abs(r[:, None] - r[None, :]))
    q_decay = jnp.exp(log_g[:, None] * (r + 1.0))
    k_decay = jnp.exp(log_g[:, None] * (CHUNK - 1.0 - r))
    chunk_decay = jnp.exp(log_g * CHUNK)

    def to_chunks(t):
        return t.reshape(B, NC, CHUNK, t.shape[2], t.shape[3]).transpose(1, 0, 3, 2, 4)

    qc, kc, vc = to_chunks(q), to_chunks(k), to_chunks(v)

    def step(state, inp):
        qi, ki, vi = inp
        s = jnp.einsum('bhnd,bhmd->bhnm', qi, ki).astype(jnp.float32) * intra_decay[None]
        inner = jnp.einsum('bhnm,bhmv->bhnv', s, vi.astype(jnp.float32))
        cross = jnp.einsum('bhnd,bhdv->bhnv', qi.astype(jnp.float32), state) * q_decay[None, :, :, None]
        kd = ki.astype(jnp.float32) * k_decay[None, :, :, None]
        new_state = state * chunk_decay[None, :, None, None] + jnp.einsum(
            'bhmd,bhmv->bhdv', kd, vi.astype(jnp.float32))
        return new_state, inner + cross

    state0 = jnp.zeros((B, RET_HEADS, RET_QK_DIM, RET_V_DIM), jnp.float32)
    _, o = lax.scan(step, state0, (qc, kc, vc))
    o = o.transpose(1, 0, 3, 2, 4).reshape(B, S, RET_HEADS, RET_V_DIM)
    o = o * lax.rsqrt(jnp.mean(o * o, axis=-1, keepdims=True) + EPS)
    o = o.reshape(B, S, RET_HV)
    y = (jax.nn.silu(g.astype(jnp.float32)) * o).astype(h.dtype)
    return y @ w_out


def chunk_attention(h, w_in, w_out, rel_bias):
    B, S, _ = h.shape
    NC = S // CHUNK
    pad = LEFT_CHUNKS * CHUNK
    proj = h @ w_in
    q, k, v = jnp.split(proj, 3, axis=-1)
    q = q.reshape(B, S, ATT_HEADS, ATT_HEAD_DIM)
    k = k.reshape(B, S, ATT_HEADS, ATT_HEAD_DIM)
    v = v.reshape(B, S, ATT_HEADS, ATT_HEAD_DIM)
    kp = jnp.pad(k, ((0, 0), (pad, 0), (0, 0), (0, 0)))
    vp = jnp.pad(v, ((0, 0), (pad, 0), (0, 0), (0, 0)))

    s_idx = jnp.arange(BAND)
    r_idx = jnp.arange(CHUNK)
    dist = r_idx[:, None] + pad - s_idx[None, :]
    bias = rel_bias.astype(jnp.float32)[:, jnp.clip(dist, -REL_CLIP, REL_CLIP) + REL_CLIP]
    scale = ATT_HEAD_DIM ** -0.5

    def one_chunk(c):
        qi = lax.dynamic_slice_in_dim(q, c * CHUNK, CHUNK, axis=1)
        ki = lax.dynamic_slice_in_dim(kp, c * CHUNK, BAND, axis=1)
        vi = lax.dynamic_slice_in_dim(vp, c * CHUNK, BAND, axis=1)
        valid = (c * CHUNK - pad + s_idx) >= 0
        logits = jnp.einsum('bqhd,bkhd->bhqk', qi, ki).astype(jnp.float32) * scale + bias[None]
        logits = jnp.where(valid[None, None, None, :], logits, jnp.float32(NEG_INF))
        p = jax.nn.softmax(logits, axis=-1)
        return jnp.einsum('bhqk,bkhd->bqhd', p.astype(vi.dtype), vi)

    out = lax.map(one_chunk, jnp.arange(NC))
    out = out.transpose(1, 0, 2, 3, 4).reshape(B, S, D_MODEL)
    return out @ w_out


def swiglu(h, w_in, w_out):
    gu = h @ w_in
    g, u = jnp.split(gu, 2, axis=-1)
    return (jax.nn.silu(g.astype(jnp.float32)) * u.astype(jnp.float32)).astype(h.dtype) @ w_out


def moe_swiglu(h, w_router, w_in, w_out):
    B, S, D = h.shape
    ht = h.reshape(B * S, D)
    logits = (ht @ w_router).astype(jnp.float32)
    top_val, top_idx = lax.top_k(logits, TOP_K)
    gates = jax.nn.softmax(top_val, axis=-1)
    combine = jnp.sum(jax.nn.one_hot(top_idx, N_EXPERTS, dtype=jnp.float32) * gates[..., None], axis=1)
    out = jnp.zeros((B * S, D), jnp.float32)
    for e in range(N_EXPERTS):
        y = swiglu(ht, w_in[e], w_out[e]).astype(jnp.float32)
        out = out + combine[:, e:e + 1] * y
    return out.astype(h.dtype).reshape(B, S, D)


def setup_inputs(seed: int = 0) -> dict:
    key = jax.random.key(seed)
    ks = jax.random.split(key, 16)
    f32 = jnp.float32

    def w(k, shape, fan_in):
        return jax.random.normal(k, shape, f32) * (fan_in ** -0.5)

    return {
        "x": jax.random.normal(ks[0], (BATCH, SEQ, D_MODEL), f32),
        "ln_mix": 1.0 + 0.02 * jax.random.normal(ks[1], (DEPTH, D_MODEL), f32),
        "ln_ffn": 1.0 + 0.02 * jax.random.normal(ks[2], (DEPTH, D_MODEL), f32),
        "ln_final": 1.0 + 0.02 * jax.random.normal(ks[3], (D_MODEL,), f32),
        "ret_w_in": w(ks[4], (N_A, D_MODEL, 2 * D_MODEL + 2 * RET_HV), D_MODEL),
        "ret_w_out": w(ks[5], (N_A, RET_HV, D_MODEL), RET_HV),
        "ffn_w_in": w(ks[6], (N_A, D_MODEL, 2 * D_FF), D_MODEL),
        "ffn_w_out": w(ks[7], (N_A, D_FF, D_MODEL), D_FF),
        "att_w_in": w(ks[8], (N_B, D_MODEL, 3 * D_MODEL), D_MODEL),
        "att_w_out": w(ks[9], (N_B, D_MODEL, D_MODEL), D_MODEL),
        "att_rel_bias": 0.2 * jax.random.normal(ks[10], (N_B, ATT_HEADS, 2 * REL_CLIP + 1), f32),
        "moe_router": w(ks[11], (N_B, D_MODEL, N_EXPERTS), D_MODEL),
        "moe_w_in": w(ks[12], (N_B, N_EXPERTS, D_MODEL, 2 * D_FF_EXPERT), D_MODEL),
        "moe_w_out": w(ks[13], (N_B, N_EXPERTS, D_FF_EXPERT, D_MODEL), D_FF_EXPERT),
    }


def reference(x, ln_mix, ln_ffn, ln_final, ret_w_in, ret_w_out, ffn_w_in, ffn_w_out,
              att_w_in, att_w_out, att_rel_bias, moe_router, moe_w_in, moe_w_out):
    for i in range(DEPTH):
        j = i // 2
        h = rmsnorm(x, ln_mix[i])
        if i % 2 == 0:
            x = x + retention(h, ret_w_in[j], ret_w_out[j])
        else:
            x = x + chunk_attention(h, att_w_in[j], att_w_out[j], att_rel_bias[j])
        h = rmsnorm(x, ln_ffn[i])
        if i % 2 == 0:
            x = x + swiglu(h, ffn_w_in[j], ffn_w_out[j])
        else:
            x = x + moe_swiglu(h, moe_router[j], moe_w_in[j], moe_w_out[j])
    return rmsnorm(x, ln_final)
```

```cpp
#include <hip/hip_runtime.h>
#include <cstdio>
#include <cstdint>

#ifndef DBG_STAGE
#define DBG_STAGE 100
#endif
#ifndef DUP_MASK
#define EPI_DUP 0
#define DUP_MASK 0
#endif
#ifndef I8_MOE
#define I8_MOE 1
#endif
#ifndef I8_QKV
#define I8_QKV 1
#endif
#ifndef I8_RIN
#define F8_FOUT 1
#define I8_RIN 1
#endif
#ifndef MK_PER_PHASE
#define MK_PER_PHASE 0
#endif

#define GAS __attribute__((address_space(1)))
#define LAS __attribute__((address_space(3)))
typedef unsigned short bf16_t;
typedef short bf16x8 __attribute__((ext_vector_type(8)));
typedef short s16x4 __attribute__((ext_vector_type(4)));
typedef float f32x4 __attribute__((ext_vector_type(4)));
typedef float f32x16 __attribute__((ext_vector_type(16)));
typedef unsigned u32x4 __attribute__((ext_vector_type(4)));
typedef unsigned u32x2 __attribute__((ext_vector_type(2)));

constexpr int DM = 2048, NBATCH = 8, SEQ = 2048, T = NBATCH * SEQ, CHUNK = 64;
constexpr int RH = 8, RDK = 256, RDV = 512, RHV = RH * RDV, NRET = 2 * DM + 2 * RHV;
constexpr int AH = 16, AD = 128, NATT = 3 * DM;
constexpr int FF = 5632, NE = 8, FE = 7168;
constexpr int MOE_ROWS = 2 * T + NE * 256;
constexpr float EPS = 1e-6f;
constexpr float LOG2E = 1.4426950408889634f;
constexpr int NWAVES = 8;
constexpr float H8_SCALE = 32.f, W1_SCALE = 1024.f, A2_SCALE = 4.f, W2_SCALE = 2048.f;
constexpr float HI8_SCALE = 127.f / 4.f, WI8_SCALE = 127.f * 45.254833995939045f / 4.f, I8_DESCALE = 1.0f / (HI8_SCALE * WI8_SCALE);
constexpr unsigned SB_H8 = 0x7a7a7a7au  , SB_W1 = 0x75757575u  , SB_A2 = 0x7d7d7d7du  , SB_W2 = 0x74747474u  , SB_W1U = 0x77777777u  ;

constexpr size_t MiB = 1u << 20;
constexpr size_t WS_CTL = 0, CTL_ZERO_BYTES = 1 * MiB;
constexpr size_t WS_W_RIN = 2 * MiB, WS_W_ROUT = 50 * MiB, WS_W_FIN = 66 * MiB, WS_W_FOUT = 110 * MiB, WS_W_AIN = 132 * MiB, WS_W_AOUT = 156 * MiB;
constexpr size_t WS_W_MIN = 164 * MiB, WS_W_MOUT = 612 * MiB;
constexpr size_t WS_H = 836 * MiB;
constexpr size_t WS_A = 900 * MiB;
constexpr size_t WS_B = 1376 * MiB;
constexpr size_t WS_Y = 1512 * MiB;
constexpr size_t WS_X1 = 1640 * MiB, WS_X2 = 1768 * MiB, WS_X3 = 1896 * MiB;
constexpr size_t WS_YB = 2300 * MiB;
constexpr size_t WS_SSP = 2296 * MiB;
constexpr size_t WS_LIST = 2298 * MiB;
constexpr size_t WS_TOK = 2299 * MiB;
constexpr size_t WS_AGC = 2300 * MiB + 4 * 136 * MiB;
constexpr size_t WS_END = WS_AGC + 256 * MiB;
constexpr int CW_TMO = 0, CW_BAR = 4096, CW_CNT = 8192;

constexpr int RING_BYTES = 143360;
static_assert(8 * 16640 <= RING_BYTES && 131072 <= RING_BYTES, "phase scratch must stay below the LDS control words");
constexpr int LDSCTL_OFF = RING_BYTES, MISC_OFF = LDSCTL_OFF + 320;
constexpr int LDS_BYTES = 147456;

#define LDS_WAIT() asm volatile("s_waitcnt lgkmcnt(0)" ::: "memory")
#define VM_WAIT() asm volatile("s_waitcnt vmcnt(0)" ::: "memory")
#define RLX_AGENT __ATOMIC_RELAXED, __HIP_MEMORY_SCOPE_AGENT

__device__ __forceinline__ unsigned cvt_pk_bf16(float lo, float hi) { unsigned r; asm volatile("v_cvt_pk_bf16_f32 %0, %1, %2" : "=v"(r) : "v"(lo), "v"(hi)); return r; }
__device__ __forceinline__ float bf_lo(unsigned w) { return __uint_as_float(w << 16); }
__device__ __forceinline__ float bf_hi(unsigned w) { return __uint_as_float(w & 0xffff0000u); }
__device__ __forceinline__ float silu_f(float x) { return x * __builtin_amdgcn_rcpf(1.0f + __builtin_amdgcn_exp2f(-x * LOG2E)); }
__device__ __forceinline__ unsigned pk4_i8(float a, float b, float c, float d, float sc) {
    const int ia = (int)__builtin_rintf(__builtin_amdgcn_fmed3f(a * sc, -127.f, 127.f)), ib = (int)__builtin_rintf(__builtin_amdgcn_fmed3f(b * sc, -127.f, 127.f));
    const int ic = (int)__builtin_rintf(__builtin_amdgcn_fmed3f(c * sc, -127.f, 127.f)), id = (int)__builtin_rintf(__builtin_amdgcn_fmed3f(d * sc, -127.f, 127.f));
    return ((unsigned)ia & 0xffu) | (((unsigned)ib & 0xffu) << 8) | (((unsigned)ic & 0xffu) << 16) | ((unsigned)id << 24);
}
__device__ __forceinline__ float wave_sum(float v) {
    v += __builtin_bit_cast(float, __builtin_amdgcn_update_dpp(0, __builtin_bit_cast(int, v), 0xB1, 0xf, 0xf, true));
    v += __builtin_bit_cast(float, __builtin_amdgcn_update_dpp(0, __builtin_bit_cast(int, v), 0x4E, 0xf, 0xf, true));
    v += __builtin_bit_cast(float, __builtin_amdgcn_update_dpp(0, __builtin_bit_cast(int, v), 0x141, 0xf, 0xf, true));
    v += __builtin_bit_cast(float, __builtin_amdgcn_update_dpp(0, __builtin_bit_cast(int, v), 0x140, 0xf, 0xf, true));
    const int vi = __builtin_bit_cast(int, v);
    return (__builtin_bit_cast(float, __builtin_amdgcn_readlane(vi, 0)) + __builtin_bit_cast(float, __builtin_amdgcn_readlane(vi, 16)))
         + (__builtin_bit_cast(float, __builtin_amdgcn_readlane(vi, 32)) + __builtin_bit_cast(float, __builtin_amdgcn_readlane(vi, 48)));
}

namespace pg8 {
typedef int v4i32 __attribute__((ext_vector_type(4)));
constexpr int BM = 256, BK = 64, HALF = 128, HTB = HALF * BK * 2, STAGE_BYTES = 8 * HTB, NXCD = 8, WGM = 4;
__host__ __device__ __forceinline__ int lds_byte(int r, int c) { const int st = (r >> 4) * 2 + (c >> 5), rr = r & 15, cc = c & 31, ob = rr * 64 + cc * 2; return st * 1024 + (ob ^ (((ob >> 9) & 1) << 5)); }
__host__ __device__ __forceinline__ void stage_rc(int b, int& R, int& C) { const int st = b / 1024, sb = b % 1024, swz = sb ^ (((sb >> 9) & 1) << 5); R = (st >> 1) * 16 + swz / 64; C = (st & 1) * 32 + (swz % 64) / 2; }
__host__ __device__ __forceinline__ int perm32(int rho) { const int n = rho >> 4, i = rho & 15; return 8 * (i >> 2) + 4 * n + (i & 3); }

struct Unit { int pm, pn; unsigned boff; unsigned koff; int nt, part, arow; };
struct Gemm { const bf16_t* A; const bf16_t* Bt; int M, N, K; unsigned sW, sA, sWu; };

struct StaticOrder {
    int nM, nN, nwg, G, c, nt0;
    __device__ __forceinline__ void init(int M, int N, int K, int G_, int c_) { nM = M / BM; nN = N / BM; nwg = nM * nN; G = G_; c = c_; nt0 = K / BK; }
    __device__ __forceinline__ bool next(int i, Unit& u) const {
        const long L = (long)i * G + c; if (L >= nwg) return false;
        int wgid = (int)L; { const int q = nwg / NXCD, r = nwg % NXCD, xcd = wgid % NXCD, off = wgid / NXCD; wgid = (xcd < r ? xcd * (q + 1) : r * (q + 1) + (xcd - r) * q) + off; }
        const int nig = WGM * nN, gid = wgid / nig, fm = gid * WGM, gsz = (nM - fm) < WGM ? (nM - fm) : WGM;
        u.pm = fm + ((wgid % nig) % gsz); u.pn = (wgid % nig) / gsz; u.boff = 0; u.koff = 0; u.nt = nt0; u.part = 0; u.arow = u.pm * BM; return true;
    }
    __device__ __forceinline__ void a_ready(const Unit&) const {}
    __device__ __forceinline__ void done(const Unit&) const {}
};
struct MoeOrder {
    int nM, nN, nwg, G, c, nt0, aseg; int toff[9]; unsigned estride;
    __device__ __forceinline__ bool next(int i, Unit& u) const {
        const long L = (long)i * G + c; if (L >= nwg) return false;
        int wgid = (int)L; { const int q = nwg / NXCD, r = nwg % NXCD, xcd = wgid % NXCD, off = wgid / NXCD; wgid = (xcd < r ? xcd * (q + 1) : r * (q + 1) + (xcd - r) * q) + off; }
        const int CG = nN / NXCD, nig = CG * nM, gid = wgid / nig, fn = gid * CG;
        u.pn = fn + ((wgid % nig) % CG); u.pm = (wgid % nig) / CG;
        int e = 0;
#pragma unroll
        for (int j = 1; j < 8; ++j) e += (u.pm >= toff[j]) ? 1 : 0;
        u.boff = (unsigned)e * estride; u.koff = 0; u.nt = nt0; u.part = 0; { int te = 0;
#pragma unroll
          for (int j = 1; j < 8; ++j) te = (u.pm >= toff[j]) ? toff[j] : te;
          u.arow = e * aseg + (u.pm - te) * BM; } return true;
    }
    __device__ __forceinline__ void a_ready(const Unit&) const {}
    __device__ __forceinline__ void done(const Unit&) const {}
};

struct MoeTailOrder {
    int nM, nMf, nN, G, c, nt0, S; int toff[9]; unsigned estride;
    __device__ __forceinline__ void init(int nM_, int nN_, int K, int G_, int c_) { nM = nM_; nN = nN_; G = G_; c = c_; nt0 = K / BK;
        const int nwg = nM * nN, rem = nwg % G; S = (rem == 0 || rem * 2 > G) ? 1 : (rem * 4 > G ? 2 : 4); nMf = (S == 1) ? nM : nM - rem / nN; }
    __device__ __forceinline__ bool next(int i, Unit& u) const {
        const int nfull = nMf * nN; const int L = i * G + c;
        int pm, pn, nt, part; unsigned koff;
        if (L < nfull) {
            int wgid = L; { const int q = nfull / NXCD, r = nfull % NXCD, xcd = wgid % NXCD, off = wgid / NXCD; wgid = (xcd < r ? xcd * (q + 1) : r * (q + 1) + (xcd - r) * q) + off; }
            const int nig = WGM * nN, gid = wgid / nig, fm = gid * WGM, gsz = (nMf - fm) < WGM ? (nMf - fm) : WGM;
            pm = fm + ((wgid % nig) % gsz); pn = (wgid % nig) / gsz; koff = 0u; nt = nt0; part = 0;
        } else {
            const int j = L - nfull, ntail = (nM - nMf) * nN;
            if (j >= ntail * S) return false;
            const int tu = j / S, p = j - tu * S;
            pm = nMf + tu / nN; pn = tu % nN; nt = nt0 / S; koff = (unsigned)(p * nt * BK * 2); part = p;
        }
        int e = 0;
        e += (pm >= toff[1]) ? 1 : 0; e += (pm >= toff[2]) ? 1 : 0; e += (pm >= toff[3]) ? 1 : 0; e += (pm >= toff[4]) ? 1 : 0; e += (pm >= toff[5]) ? 1 : 0; e += (pm >= toff[6]) ? 1 : 0; e += (pm >= toff[7]) ? 1 : 0;
        u.pm = pm; u.pn = pn; u.boff = (unsigned)e * estride; u.koff = koff; u.nt = nt; u.part = part; u.arow = pm * BM; return true;
    }
    __device__ __forceinline__ void a_ready(const Unit&) const {}
    __device__ __forceinline__ void done(const Unit&) const {}
};
template <bool INT> __device__ __forceinline__ f32x4 accv(const f32x4& a, float dsc) { if constexpr (INT) return __builtin_convertvector(__builtin_bit_cast(v4i32, a), f32x4) * dsc; else return a; }
template <bool INT> struct EpiBf16T {
    static constexpr bool PERM = true, AFTER_DRAIN = false;
    bf16_t* O; int ldc; size_t pstride; float dsc;
    __device__ __forceinline__ void operator()(const f32x4 (&acc)[2][2][4][2], const Unit& u, int wr, int wc, int fr, int fq) const {
        const unsigned lo = (unsigned)((wr * 64 + fr) * ldc + u.pn * BM + wc * 32 + 8 * fq);
#pragma unroll
        for (int ai = 0; ai < 2; ++ai)
#pragma unroll
            for (int m = 0; m < 4; ++m) { bf16_t* rb = O + (size_t)u.part * pstride + (size_t)(u.pm * BM + ai * HALF + m * 16) * ldc;
#pragma unroll
                for (int bj = 0; bj < 2; ++bj) { const f32x4 v0 = accv<INT>(acc[ai][bj][m][0], dsc), v1 = accv<INT>(acc[ai][bj][m][1], dsc);
                    u32x4 w; w.x = cvt_pk_bf16(v0[0], v0[1]); w.y = cvt_pk_bf16(v0[2], v0[3]); w.z = cvt_pk_bf16(v1[0], v1[1]); w.w = cvt_pk_bf16(v1[2], v1[3]);
                    *(u32x4*)(rb + lo + bj * HALF) = w; } }
    }
};
typedef EpiBf16T<false> EpiBf16;
template <bool INT> struct EpiRetInT {
    static constexpr bool PERM = true, AFTER_DRAIN = false;
    bf16_t* O; int ldc; float dsc;
    __device__ __forceinline__ void operator()(const f32x4 (&acc)[2][2][4][2], const Unit& u, int wr, int wc, int fr, int fq) const {
        const int row0 = u.pm * BM + wr * 64 + fr;
        const unsigned lo = (unsigned)((wr * 64 + fr) * ldc + u.pn * BM + wc * 32 + 8 * fq);
        if (u.pn < 16) {
            const float ksc = (u.pn >= 8) ? 0.0625f : 1.0f;
            float rf[2][4];
#pragma unroll
            for (int n = 0; n < 2; ++n)
#pragma unroll
                for (int e = 0; e < 4; ++e) { const float d = (float)(wc * 32 + 8 * fq + 4 * n + e);
                    rf[n][e] = __builtin_amdgcn_exp2f(d * (-13.287712379549449f / 128.0f)) * 0.15915494309189535f; }
#pragma unroll
            for (int ai = 0; ai < 2; ++ai)
#pragma unroll
                for (int m = 0; m < 4; ++m) { const int row = row0 + ai * HALF + m * 16; const float pos = (float)(row & (SEQ - 1));
                    bf16_t* rowp = O + (size_t)(u.pm * BM + ai * HALF + m * 16) * ldc + lo;
                    f32x4 o1[2], o2[2];
#pragma unroll
                    for (int n = 0; n < 2; ++n) { const f32x4 x1 = accv<INT>(acc[ai][0][m][n], dsc), x2 = accv<INT>(acc[ai][1][m][n], dsc);
#pragma unroll
                        for (int e = 0; e < 4; ++e) { const float ph = __builtin_amdgcn_fractf(pos * rf[n][e]);
                            const float sn = __builtin_amdgcn_sinf(ph), cs = __builtin_amdgcn_cosf(ph);
                            o1[n][e] = (x1[e] * cs - x2[e] * sn) * ksc; o2[n][e] = (x1[e] * sn + x2[e] * cs) * ksc; } }
                    u32x4 w; w.x = cvt_pk_bf16(o1[0][0], o1[0][1]); w.y = cvt_pk_bf16(o1[0][2], o1[0][3]); w.z = cvt_pk_bf16(o1[1][0], o1[1][1]); w.w = cvt_pk_bf16(o1[1][2], o1[1][3]);
                    *(u32x4*)(rowp) = w;
                    w.x = cvt_pk_bf16(o2[0][0], o2[0][1]); w.y = cvt_pk_bf16(o2[0][2], o2[0][3]); w.z = cvt_pk_bf16(o2[1][0], o2[1][1]); w.w = cvt_pk_bf16(o2[1][2], o2[1][3]);
                    *(u32x4*)(rowp + HALF) = w; }
        } else {
#pragma unroll
            for (int ai = 0; ai < 2; ++ai)
#pragma unroll
                for (int m = 0; m < 4; ++m) { bf16_t* rb = O + (size_t)(u.pm * BM + ai * HALF + m * 16) * ldc;
#pragma unroll
                    for (int bj = 0; bj < 2; ++bj) { const f32x4 v0 = accv<INT>(acc[ai][bj][m][0], dsc), v1 = accv<INT>(acc[ai][bj][m][1], dsc);
                        u32x4 w; w.x = cvt_pk_bf16(v0[0], v0[1]); w.y = cvt_pk_bf16(v0[2], v0[3]); w.z = cvt_pk_bf16(v1[0], v1[1]); w.w = cvt_pk_bf16(v1[2], v1[3]);
                        *(u32x4*)(rb + lo + bj * HALF) = w; } }
        }
    }
};
typedef EpiRetInT<false> EpiRetIn;
struct EpiSwiglu {
    static constexpr bool PERM = true, AFTER_DRAIN = false;
    bf16_t* O; int ldc;
    __device__ __forceinline__ void operator()(const f32x4 (&acc)[2][2][4][2], const Unit& u, int wr, int wc, int fr, int fq) const {
        const unsigned lo = (unsigned)((wr * 64 + fr) * ldc + u.pn * HALF + wc * 32 + 8 * fq);
#pragma unroll
        for (int ai = 0; ai < 2; ++ai)
#pragma unroll
            for (int m = 0; m < 4; ++m) { bf16_t* rowp = O + (size_t)(u.pm * BM + ai * HALF + m * 16) * ldc + lo;
                f32x4 v[2];
#pragma unroll
                for (int n = 0; n < 2; ++n) { const f32x4 g = acc[ai][0][m][n], uu = acc[ai][1][m][n];
                    const f32x4 t = g * (-LOG2E); f32x4 d;
#pragma unroll
                    for (int e = 0; e < 4; ++e) d[e] = __builtin_amdgcn_exp2f(t[e]);
                    d = d + 1.0f;
#pragma unroll
                    for (int e = 0; e < 4; ++e) d[e] = __builtin_amdgcn_rcpf(d[e]);
                    v[n] = (g * uu) * d; }
                u32x4 w; w.x = cvt_pk_bf16(v[0][0], v[0][1]); w.y = cvt_pk_bf16(v[0][2], v[0][3]); w.z = cvt_pk_bf16(v[1][0], v[1][1]); w.w = cvt_pk_bf16(v[1][2], v[1][3]);
                *(u32x4*)(rowp) = w; }
    }
};
struct EpiSwigluI {
    static constexpr bool PERM = true, AFTER_DRAIN = false;
    bf16_t* O; int ldc; float dsc;
    __device__ __forceinline__ void operator()(const f32x4 (&acc)[2][2][4][2], const Unit& u, int wr, int wc, int fr, int fq) const {
        const unsigned lo = (unsigned)((wr * 64 + fr) * ldc + u.pn * HALF + wc * 32 + 8 * fq);
#pragma unroll
        for (int ai = 0; ai < 2; ++ai)
#pragma unroll
            for (int m = 0; m < 4; ++m) { bf16_t* rowp = O + (size_t)(u.pm * BM + ai * HALF + m * 16) * ldc + lo;
                f32x4 v[2];
#pragma unroll
                for (int n = 0; n < 2; ++n) { const f32x4 g = __builtin_convertvector(__builtin_bit_cast(v4i32, acc[ai][0][m][n]), f32x4), uu = __builtin_convertvector(__builtin_bit_cast(v4i32, acc[ai][1][m][n]), f32x4);
                    const f32x4 t = g * (-LOG2E * dsc); f32x4 d;
#pragma unroll
                    for (int e = 0; e < 4; ++e) d[e] = __builtin_amdgcn_exp2f(t[e]);
                    d = d + 1.0f;
#pragma unroll
                    for (int e = 0; e < 4; ++e) d[e] = __builtin_amdgcn_rcpf(d[e]);
                    v[n] = (g * uu) * (d * (dsc * dsc)); }
                u32x4 w; w.x = cvt_pk_bf16(v[0][0], v[0][1]); w.y = cvt_pk_bf16(v[0][2], v[0][3]); w.z = cvt_pk_bf16(v[1][0], v[1][1]); w.w = cvt_pk_bf16(v[1][2], v[1][3]);
                *(u32x4*)(rowp) = w; }
    }
};
template <bool INT> struct EpiSwiglu8T {
    static constexpr bool PERM = true, AFTER_DRAIN = false;
    unsigned char* O; int ldc; float oscale, dsc;
    __device__ __forceinline__ void operator()(const f32x4 (&acc)[2][2][4][2], const Unit& u, int wr, int wc, int fr, int fq) const {
        const unsigned lo = (unsigned)((wr * 64 + fr) * ldc + u.pn * HALF + wc * 32 + 8 * fq);
#pragma unroll
        for (int ai = 0; ai < 2; ++ai)
#pragma unroll
            for (int m = 0; m < 4; ++m) { unsigned char* rowp = O + (size_t)(u.pm * BM + ai * HALF + m * 16) * ldc + lo;
                f32x4 v[2];
#pragma unroll
                for (int n = 0; n < 2; ++n) {
                    const f32x4 g = INT ? __builtin_convertvector(__builtin_bit_cast(v4i32, acc[ai][0][m][n]), f32x4) : acc[ai][0][m][n];
                    const f32x4 uu = INT ? __builtin_convertvector(__builtin_bit_cast(v4i32, acc[ai][1][m][n]), f32x4) : acc[ai][1][m][n];
                    const float k1 = INT ? -LOG2E * dsc : -LOG2E, k2 = INT ? dsc * dsc * oscale : oscale;
                    const f32x4 t = g * k1; f32x4 d;
#pragma unroll
                    for (int e = 0; e < 4; ++e) d[e] = __builtin_amdgcn_exp2f(t[e]);
                    d = d + 1.0f;
#pragma unroll
                    for (int e = 0; e < 4; ++e) d[e] = __builtin_amdgcn_rcpf(d[e]);
                    const f32x4 o = (g * uu) * (d * k2);
#pragma unroll
                    for (int e = 0; e < 4; ++e) v[n][e] = __builtin_amdgcn_fmed3f(o[e], -448.f, 448.f); }
                u32x2 w; int t = 0;
                t = __builtin_amdgcn_cvt_pk_fp8_f32(v[0][0], v[0][1], t, false); t = __builtin_amdgcn_cvt_pk_fp8_f32(v[0][2], v[0][3], t, true); w.x = (unsigned)t;
                t = __builtin_amdgcn_cvt_pk_fp8_f32(v[1][0], v[1][1], t, false); t = __builtin_amdgcn_cvt_pk_fp8_f32(v[1][2], v[1][3], t, true); w.y = (unsigned)t;
                *(u32x2*)(rowp) = w; }
    }
};
typedef EpiSwiglu8T<false> EpiSwiglu8;
struct EpiResF32 {
    static constexpr bool PERM = false, AFTER_DRAIN = false;
    const float* base; float* out; int ldc;
    __device__ __forceinline__ void operator()(const f32x4 (&acc)[2][2][4][2], const Unit& u, int wr, int wc, int fr, int fq) const {
        const unsigned lo = (unsigned)((wr * 64 + fr) * ldc + u.pn * BM + wc * 32 + 4 * fq);
#pragma unroll
        for (int ai = 0; ai < 2; ++ai)
#pragma unroll
            for (int m = 0; m < 4; ++m) { const size_t rg = (size_t)(u.pm * BM + ai * HALF + m * 16) * ldc;
#pragma unroll
                for (int bj = 0; bj < 2; ++bj)
#pragma unroll
                    for (int n = 0; n < 2; ++n) { f32x4 o = acc[ai][bj][m][n]; if (base) o = o + *(const f32x4*)(base + rg + lo + bj * HALF + n * 16);
                        *(f32x4*)(out + rg + lo + bj * HALF + n * 16) = o; } }
    }
};

template <bool BASE_BF16> struct EpiResB {
    static constexpr bool PERM = true, AFTER_DRAIN = false;
    const void* base; bf16_t* out; int ldc;
    __device__ __forceinline__ void operator()(const f32x4 (&acc)[2][2][4][2], const Unit& u, int wr, int wc, int fr, int fq) const {
        const unsigned lo = (unsigned)((wr * 64 + fr) * ldc + u.pn * BM + wc * 32 + 8 * fq);
#pragma unroll
        for (int ai = 0; ai < 2; ++ai)
#pragma unroll
            for (int m = 0; m < 4; ++m) { const size_t rg = (size_t)(u.pm * BM + ai * HALF + m * 16) * ldc;
#pragma unroll
                for (int bj = 0; bj < 2; ++bj) { f32x4 v0 = acc[ai][bj][m][0], v1 = acc[ai][bj][m][1];
                    if constexpr (BASE_BF16) { const u32x4 b = *(const u32x4*)((const bf16_t*)base + rg + lo + bj * HALF);
                        v0 = v0 + (f32x4){bf_lo(b.x), bf_hi(b.x), bf_lo(b.y), bf_hi(b.y)}; v1 = v1 + (f32x4){bf_lo(b.z), bf_hi(b.z), bf_lo(b.w), bf_hi(b.w)}; }
                    else { const float* bp = (const float*)base + rg + lo + bj * HALF; v0 = v0 + *(const f32x4*)bp; v1 = v1 + *(const f32x4*)(bp + 4); }
                    u32x4 w; w.x = cvt_pk_bf16(v0[0], v0[1]); w.y = cvt_pk_bf16(v0[2], v0[3]); w.z = cvt_pk_bf16(v1[0], v1[1]); w.w = cvt_pk_bf16(v1[2], v1[3]);
                    *(u32x4*)(out + rg + lo + bj * HALF) = w; } }
    }
};

typedef int v8i32 __attribute__((ext_vector_type(8)));
template <class Epi, class Sched, bool ALIGN_EPI = false, bool SP2 = false, bool F8 = false, bool I8 = false>
__device__ __forceinline__ void gemm_phase(LAS unsigned char* lds, const int tid, const Gemm g, const Sched& S, const Epi& E) {
    const int wid = __builtin_amdgcn_readfirstlane(tid >> 6), lane = tid & 63, wr = wid >> 2, wc = wid & 3, fr = lane & 15, fq = lane >> 4;
    const int K = g.K;
    unsigned voffA[2], voffB[2];
#pragma unroll
    for (int i = 0; i < 2; ++i) { int R, C; stage_rc(tid * 16 + i * 8192, R, C); const int Rb = Epi::PERM ? ((R & ~31) + perm32(R & 31)) : R;
        voffA[i] = (unsigned)(R * K + C) * 2u; voffB[i] = (unsigned)(Rb * K + C) * 2u; }
    const __amdgpu_buffer_rsrc_t rsA = __builtin_amdgcn_make_buffer_rsrc((void*)g.A, 0, 0xffffffff, 0x00020000);
    const __amdgpu_buffer_rsrc_t rsB = __builtin_amdgcn_make_buffer_rsrc((void*)g.Bt, 0, 0xffffffff, 0x00020000);
    const int kstep = BK * 2;
    const int hstep = HALF * K * 2;
    const int tstep = 2 * hstep;
    const unsigned ldsw = (unsigned)wid * 1024u;
    const int aoff = lds_byte(wr * 64 + fr, fq * 8), boff = lds_byte(wc * 32 + fr, fq * 8);
#define PG8_SA(b, h) (((b) * 2 + (h)) * HTB)
#define PG8_SB(b, h) ((4 + (b) * 2 + (h)) * HTB)
#define PG8_RS_voffA rsA
#define PG8_RS_voffB rsB
#define PG8_STAGE(bufoff, soff, voff) do { _Pragma("unroll") for (int _i = 0; _i < 2; ++_i) \
        __builtin_amdgcn_raw_ptr_buffer_load_lds(PG8_RS_##voff, (LAS void*)(lds + (bufoff) + ldsw + _i * 8192), 16, (int)(voff)[_i], (int)(soff), 0, 0); } while (0)
#define PG8_LD8(p) __builtin_bit_cast(v8i32, __builtin_shufflevector(*(const LAS u32x4*)(p), *(const LAS u32x4*)((p) + 1024), 0, 1, 2, 3, 4, 5, 6, 7))
#define PG8_LDA(dst, b, h) do { if constexpr (F8) { _Pragma("unroll") for (int m = 0; m < 4; ++m) dst##8[m] = PG8_LD8(lds + PG8_SA(b, h) + aoff + m * 2048); } \
        else { _Pragma("unroll") for (int m = 0; m < 4; ++m) _Pragma("unroll") for (int k = 0; k < 2; ++k) dst[m][k] = *(const LAS bf16x8*)(lds + PG8_SA(b, h) + aoff + m * 2048 + k * 1024); } } while (0)
#define PG8_LDB(dst, b, h) do { if constexpr (F8) { _Pragma("unroll") for (int n = 0; n < 2; ++n) dst##8[n] = PG8_LD8(lds + PG8_SB(b, h) + boff + n * 2048); } \
        else { _Pragma("unroll") for (int n = 0; n < 2; ++n) _Pragma("unroll") for (int k = 0; k < 2; ++k) dst[n][k] = *(const LAS bf16x8*)(lds + PG8_SB(b, h) + boff + n * 2048 + k * 1024); } } while (0)
#define PG8_MMA(ai, bj, At, Bt) do { __builtin_amdgcn_s_setprio(1); \
        if constexpr (F8) { _Pragma("unroll") for (int m = 0; m < 4; ++m) _Pragma("unroll") for (int n = 0; n < 2; ++n) \
            asm volatile("v_mfma_scale_f32_16x16x128_f8f6f4 %0, %1, %2, %0, %3, %4 op_sel_hi:[0,0,0]" : "+v"(acc[ai][bj][m][n]) : "v"(Bt##8[n]), "v"(At##8[m]), "v"((bj) ? g.sWu : g.sW), "v"(g.sA)); } \
        else if constexpr (I8) { _Pragma("unroll") for (int m = 0; m < 4; ++m) _Pragma("unroll") for (int n = 0; n < 2; ++n) _Pragma("unroll") for (int k = 0; k < 2; ++k) \
            acc[ai][bj][m][n] = __builtin_bit_cast(f32x4, __builtin_amdgcn_mfma_i32_16x16x64_i8(__builtin_bit_cast(v4i32, Bt[n][k]), __builtin_bit_cast(v4i32, At[m][k]), __builtin_bit_cast(v4i32, acc[ai][bj][m][n]), 0, 0, 0)); } \
        else { _Pragma("unroll") for (int m = 0; m < 4; ++m) _Pragma("unroll") for (int n = 0; n < 2; ++n) _Pragma("unroll") for (int k = 0; k < 2; ++k) \
            acc[ai][bj][m][n] = __builtin_amdgcn_mfma_f32_16x16x32_bf16(Bt[n][k], At[m][k], acc[ai][bj][m][n], 0, 0, 0); } \
        __builtin_amdgcn_s_setprio(0); } while (0)
#define PG8_WAIT_V(n) asm volatile("s_waitcnt vmcnt(" #n ")" ::: "memory")
#define PG8_WAIT_L(n) asm volatile("s_waitcnt lgkmcnt(" #n ")" ::: "memory")
#define PG8_BAR __builtin_amdgcn_s_barrier()
#define PG8_SCHED __builtin_amdgcn_sched_barrier(0)
    Unit cur, nxt; int ui = 0;
    if (!S.next(0, cur)) return;
    f32x4 acc[2][2][4][2];
#pragma unroll
    for (int a = 0; a < 2; ++a)
#pragma unroll
        for (int b = 0; b < 2; ++b)
#pragma unroll
            for (int m = 0; m < 4; ++m)
#pragma unroll
                for (int n = 0; n < 2; ++n) acc[a][b][m][n] = (f32x4){0.f, 0.f, 0.f, 0.f};
    bf16x8 At[4][2], B0[2][2], B1[2][2]; v8i32 At8[4], B08[2], B18[2];
    const int rstep = K * 2;
    int cA = cur.arow * rstep + (int)cur.koff; int cB = (int)cur.boff + cur.pn * tstep + (int)cur.koff;
    S.a_ready(cur);
    if constexpr (SP2) {
        PG8_STAGE(PG8_SB(0, 0), cB, voffB); PG8_STAGE(PG8_SB(0, 1), cB + hstep, voffB); PG8_STAGE(PG8_SA(0, 0), cA, voffA); PG8_STAGE(PG8_SA(0, 1), cA + hstep, voffA);
        if (wr == 1) PG8_BAR;
        PG8_WAIT_V(2); PG8_BAR;
        PG8_STAGE(PG8_SB(1, 0), cB + kstep, voffB); PG8_STAGE(PG8_SA(1, 0), cA + kstep, voffA); PG8_STAGE(PG8_SB(1, 1), cB + hstep + kstep, voffB);
        PG8_WAIT_V(6); PG8_BAR;
    } else {
        PG8_STAGE(PG8_SB(0, 0), cB, voffB); PG8_STAGE(PG8_SA(0, 0), cA, voffA); PG8_STAGE(PG8_SB(0, 1), cB + hstep, voffB); PG8_STAGE(PG8_SA(0, 1), cA + hstep, voffA);
        if (wr == 1) PG8_BAR;
        PG8_WAIT_V(4); PG8_BAR;
        PG8_STAGE(PG8_SB(1, 0), cB + kstep, voffB); PG8_STAGE(PG8_SA(1, 0), cA + kstep, voffA); PG8_STAGE(PG8_SB(1, 1), cB + hstep + kstep, voffB);
        PG8_WAIT_V(6); PG8_BAR;
    }
    for (;;) {
        const bool has_next = S.next(ui + 1, nxt);
        const int nA = has_next ? nxt.arow * rstep + (int)nxt.koff : cA; const int nB = has_next ? (int)nxt.boff + nxt.pn * tstep + (int)nxt.koff : cB;
        const int nt = cur.nt;
        for (int t = 0; t < nt; t += 2) {
            const bool last = (t == nt - 2);
            const int a1 = cA + (t + 1) * kstep;
            const int a2 = last ? nA : cA + (t + 2) * kstep; const int b2 = last ? nB : cB + (t + 2) * kstep;
            const int a3 = a2 + kstep; const int b3 = b2 + kstep;
            if (last && has_next) S.a_ready(nxt);
            if constexpr (SP2) {
            PG8_LDB(B0, 0, 0); PG8_LDB(B1, 0, 1); PG8_SCHED; PG8_LDA(At, 0, 0); PG8_STAGE(PG8_SA(1, 1), a1 + hstep, voffA);
            PG8_WAIT_V(8); PG8_WAIT_L(0); PG8_BAR; PG8_MMA(0, 0, At, B0); PG8_MMA(0, 1, At, B1); PG8_BAR; PG8_SCHED;
            PG8_LDA(At, 0, 1); PG8_STAGE(PG8_SB(0, 0), b2, voffB); PG8_STAGE(PG8_SB(0, 1), b2 + hstep, voffB); PG8_STAGE(PG8_SA(0, 0), a2, voffA);
            PG8_WAIT_V(8); PG8_WAIT_L(0); PG8_BAR; PG8_MMA(1, 0, At, B0); PG8_MMA(1, 1, At, B1); PG8_BAR; PG8_SCHED;
            PG8_LDB(B0, 1, 0); PG8_LDB(B1, 1, 1); PG8_SCHED; PG8_LDA(At, 1, 0); PG8_STAGE(PG8_SA(0, 1), a2 + hstep, voffA);
            PG8_WAIT_V(8); PG8_WAIT_L(0); PG8_BAR; PG8_MMA(0, 0, At, B0); PG8_MMA(0, 1, At, B1); PG8_BAR; PG8_SCHED;
            PG8_LDA(At, 1, 1); PG8_STAGE(PG8_SB(1, 0), b3, voffB); PG8_STAGE(PG8_SB(1, 1), b3 + hstep, voffB); PG8_STAGE(PG8_SA(1, 0), a3, voffA);
            PG8_WAIT_V(8); PG8_WAIT_L(0); PG8_BAR; PG8_MMA(1, 0, At, B0); PG8_MMA(1, 1, At, B1); PG8_BAR; PG8_SCHED;
            } else {
            PG8_LDB(B0, 0, 0); PG8_SCHED; PG8_LDA(At, 0, 0); PG8_STAGE(PG8_SA(1, 1), a1 + hstep, voffA);
            PG8_WAIT_L(8); PG8_BAR; PG8_WAIT_L(0); PG8_MMA(0, 0, At, B0); PG8_BAR; PG8_SCHED;
            PG8_LDB(B1, 0, 1); PG8_STAGE(PG8_SB(0, 0), b2, voffB);
            PG8_BAR; PG8_WAIT_L(0); PG8_MMA(0, 1, At, B1); PG8_BAR;
            PG8_LDA(At, 0, 1); PG8_STAGE(PG8_SA(0, 0), a2, voffA);
            PG8_BAR; PG8_WAIT_L(0); PG8_MMA(1, 0, At, B0); PG8_BAR; PG8_SCHED;
            PG8_STAGE(PG8_SB(0, 1), b2 + hstep, voffB);
            PG8_WAIT_V(6); PG8_BAR; PG8_MMA(1, 1, At, B1); PG8_BAR;
            PG8_LDB(B0, 1, 0); PG8_SCHED; PG8_LDA(At, 1, 0); PG8_STAGE(PG8_SA(0, 1), a2 + hstep, voffA);
            PG8_WAIT_L(8); PG8_BAR; PG8_WAIT_L(0); PG8_MMA(0, 0, At, B0); PG8_BAR; PG8_SCHED;
            PG8_LDB(B1, 1, 1); PG8_STAGE(PG8_SB(1, 0), b3, voffB);
            PG8_BAR; PG8_WAIT_L(0); PG8_MMA(0, 1, At, B1); PG8_BAR;
            PG8_LDA(At, 1, 1); PG8_STAGE(PG8_SA(1, 0), a3, voffA);
            PG8_BAR; PG8_WAIT_L(0); PG8_MMA(1, 0, At, B0); PG8_BAR; PG8_SCHED;
            PG8_STAGE(PG8_SB(1, 1), b3 + hstep, voffB);
            PG8_WAIT_V(6); PG8_BAR; PG8_MMA(1, 1, At, B1); PG8_BAR;
            }
        }
        if constexpr (F8) asm volatile("s_nop 15\n\ts_nop 15" ::: "memory");
        if constexpr (ALIGN_EPI) { if (wr == 0) PG8_BAR; }
        if constexpr (!Epi::AFTER_DRAIN) { E(acc, cur, wr, wc, fr, fq);
#if EPI_DUP
            asm volatile("" ::: "memory"); E(acc, cur, wr, wc, fr, fq);
#endif
            S.done(cur); }
        if (!has_next) break;
#pragma unroll
        for (int a = 0; a < 2; ++a)
#pragma unroll
            for (int b = 0; b < 2; ++b)
#pragma unroll
                for (int m = 0; m < 4; ++m)
#pragma unroll
                    for (int n = 0; n < 2; ++n) acc[a][b][m][n] = (f32x4){0.f, 0.f, 0.f, 0.f};
        cur = nxt; cA = nA; cB = nB; ++ui;
        if constexpr (ALIGN_EPI) { if (wr == 1) PG8_BAR; }
    }
    PG8_WAIT_V(0);
    if constexpr (!ALIGN_EPI) { if (wr == 0) PG8_BAR; }
    PG8_BAR;
#undef PG8_SA
#undef PG8_SB
#undef PG8_STAGE
#undef PG8_RS_voffA
#undef PG8_RS_voffB
#undef PG8_LDA
#undef PG8_LDB
#undef PG8_MMA
#undef PG8_LD8
#undef PG8_WAIT_V
#undef PG8_WAIT_L
#undef PG8_BAR
#undef PG8_SCHED
}
}

#define XB_TMO      128
#define XB_XCNT(j)  (256  + 64 * (j))
#define XB_XSUB(j)  (1280 + 64 * (j))
#define XB_XGEN(j)  (2304 + 64 * (j))
#define XB_TOP      3328
#define XB_TOPGEN   3392
#define XCD_BAR_WORDS 3456
#define XB_SPIN_CAP (1u << 18)

__device__ __forceinline__ unsigned xb_ld(unsigned* p)              { return __hip_atomic_load(p, __ATOMIC_RELAXED, __HIP_MEMORY_SCOPE_AGENT); }
__device__ __forceinline__ unsigned xb_add(unsigned* p, unsigned v) { return __hip_atomic_fetch_add(p, v, __ATOMIC_RELAXED, __HIP_MEMORY_SCOPE_AGENT); }
__device__ __forceinline__ unsigned xb_xcc_id() { return (unsigned)__builtin_amdgcn_s_getreg((3 << 11) | 20) & 0xFu; }
#define XB_SPIN(cond, bar) do { unsigned _sp = 0; while (cond) { __builtin_amdgcn_s_sleep(1); \
    if ((++_sp & 255u) == 0u) { if (xb_ld(&(bar)[XB_TMO])) break; if (_sp > XB_SPIN_CAP) { atomicAdd(&(bar)[XB_TMO], 1u); break; } } } } while (0)

struct XcdBarrier {
    unsigned* bar; unsigned x;
    volatile LAS unsigned* st;
};
__device__ __forceinline__ XcdBarrier xcd_barrier_post(unsigned* bar, volatile LAS unsigned* st) {
    XcdBarrier b; b.bar = bar; b.x = xb_xcc_id(); b.st = st;
    if (threadIdx.x == 0) (void)xb_add(&bar[XB_XCNT(b.x)], 1u);
    return b;
}
__device__ __forceinline__ void xcd_barrier_complete(unsigned* bar, unsigned x, unsigned& nloc, unsigned& nx) {
    const unsigned G = gridDim.x * gridDim.y * gridDim.z;
    unsigned sum, cnt, mine, sp = 0u;
    for (;;) {
        sum = 0u; cnt = 0u; mine = 0u;
#pragma unroll
        for (unsigned j = 0; j < 16; ++j) { const unsigned c = xb_ld(&bar[XB_XCNT(j)]); sum += c; cnt += (c > 0u) ? 1u : 0u; mine = (j == x) ? c : mine; }
        if (sum == G) break;
        __builtin_amdgcn_s_sleep(1);
        if ((++sp & 255u) == 0u) { if (xb_ld(&bar[XB_TMO])) break; if (sp > XB_SPIN_CAP) { atomicAdd(&bar[XB_TMO], 1u); break; } }
    }
    nloc = mine > 0u ? mine : 1u; nx = cnt > 0u ? cnt : 1u;
}
__device__ __forceinline__ void xcd_barrier(const XcdBarrier& b) {
    asm volatile("s_waitcnt vmcnt(0)" ::: "memory");
    __syncthreads();
    if (threadIdx.x == 0) {
        unsigned* bar = b.bar;
        __builtin_amdgcn_s_waitcnt(0);
        unsigned nloc = b.st[0], nx = b.st[1];
        if (nloc == 0u) { xcd_barrier_complete(bar, b.x, nloc, nx); b.st[0] = nloc; b.st[1] = nx; }
        const unsigned old = xb_add(&bar[XB_XSUB(b.x)], 1u);
        const unsigned gen = old / nloc;
        if (old + 1u == (gen + 1u) * nloc) {
            __builtin_amdgcn_fence(__ATOMIC_RELEASE, "agent");
            asm volatile("s_waitcnt vmcnt(0)" ::: "memory");
            const unsigned og = xb_add(&bar[XB_TOP], 1u);
            const unsigned tg = og / nx;
            if (og + 1u == (tg + 1u) * nx) xb_add(&bar[XB_TOPGEN], 1u);
            else XB_SPIN(xb_ld(&bar[XB_TOPGEN]) == tg, bar);
            __builtin_amdgcn_fence(__ATOMIC_ACQUIRE, "agent");
            xb_add(&bar[XB_XGEN(b.x)], 1u);
            asm volatile("s_waitcnt vmcnt(0)" ::: "memory");
        } else {
            XB_SPIN(xb_ld(&bar[XB_XGEN(b.x)]) == gen, bar);
            __builtin_amdgcn_fence(__ATOMIC_ACQUIRE, "agent");
            asm volatile("s_waitcnt vmcnt(0)" ::: "memory");
        }
    }
    __syncthreads();
}

struct Frame {
    LAS unsigned char* lds;
    unsigned* ctl;
    int tid, lane, wave;
    int vcu, G;
};

__device__ __forceinline__ int dest_row(int c, int F) { if (F == 0) return c; const int bj = (c >= F) ? 1 : 0; const int cc = c - bj * F; return (cc >> 7) * 256 + bj * 128 + (cc & 127); }
__device__ __forceinline__ void cvt_item(const float* W, int K, int N, bf16_t* WT, int F, LAS float* scr, int item, int lane) {
    const int nblk = N >> 6, kb = item / nblk, nb = item - kb * nblk, k0 = 64 * kb, n0 = 64 * nb;
    const float* src = W + (size_t)(k0 + (lane >> 4)) * N + n0 + 4 * (lane & 15);
#pragma unroll 8
    for (int i = 0; i < 16; ++i) { const f32x4 v = *(const GAS f32x4*)(src + (size_t)(4 * i) * N);
        LAS float* d = scr + (4 * i + (lane >> 4)) * 65 + 4 * (lane & 15); d[0] = v.x; d[1] = v.y; d[2] = v.z; d[3] = v.w; }
    LDS_WAIT(); asm volatile("" ::: "memory");
    const int c = lane & 7;
#pragma unroll
    for (int j = 0; j < 8; ++j) { const int n = (lane >> 3) + 8 * j; const LAS float* s = scr + (8 * c) * 65 + n;
        u32x4 o; o.x = cvt_pk_bf16(s[0 * 65], s[1 * 65]); o.y = cvt_pk_bf16(s[2 * 65], s[3 * 65]); o.z = cvt_pk_bf16(s[4 * 65], s[5 * 65]); o.w = cvt_pk_bf16(s[6 * 65], s[7 * 65]);
        *(GAS u32x4*)(WT + (size_t)dest_row(n0 + n, F) * K + k0 + 8 * c) = o; }
    LDS_WAIT(); asm volatile("" ::: "memory");
}
__device__ __forceinline__ unsigned pk4_fp8(float a, float b, float c, float d, float sc) {
    int t = 0;
    t = __builtin_amdgcn_cvt_pk_fp8_f32(__builtin_amdgcn_fmed3f(a * sc, -448.f, 448.f), __builtin_amdgcn_fmed3f(b * sc, -448.f, 448.f), t, false);
    t = __builtin_amdgcn_cvt_pk_fp8_f32(__builtin_amdgcn_fmed3f(c * sc, -448.f, 448.f), __builtin_amdgcn_fmed3f(d * sc, -448.f, 448.f), t, true);
    return (unsigned)t;
}
__device__ __forceinline__ void cvt_item8(const float* W, int K, int N, unsigned char* WT, int F, float sc, LAS float* scr, int item, int lane) {
    const int nblk = N >> 6, kb = item / nblk, nb = item - kb * nblk, k0 = 64 * kb, n0 = 64 * nb;
    const float* src = W + (size_t)(k0 + (lane >> 4)) * N + n0 + 4 * (lane & 15);
#pragma unroll 8
    for (int i = 0; i < 16; ++i) { const f32x4 v = *(const GAS f32x4*)(src + (size_t)(4 * i) * N);
        LAS float* d = scr + (4 * i + (lane >> 4)) * 65 + 4 * (lane & 15); d[0] = v.x; d[1] = v.y; d[2] = v.z; d[3] = v.w; }
    LDS_WAIT(); asm volatile("" ::: "memory");
    const int c = lane & 3;
#pragma unroll
    for (int j = 0; j < 4; ++j) { const int n = (lane >> 2) + 16 * j; const LAS float* s = scr + (16 * c) * 65 + n;
        u32x4 o; o.x = pk4_fp8(s[0 * 65], s[1 * 65], s[2 * 65], s[3 * 65], sc); o.y = pk4_fp8(s[4 * 65], s[5 * 65], s[6 * 65], s[7 * 65], sc);
        o.z = pk4_fp8(s[8 * 65], s[9 * 65], s[10 * 65], s[11 * 65], sc); o.w = pk4_fp8(s[12 * 65], s[13 * 65], s[14 * 65], s[15 * 65], sc);
        *(GAS u32x4*)(WT + (size_t)dest_row(n0 + n, F) * K + k0 + 16 * c) = o; }
    LDS_WAIT(); asm volatile("" ::: "memory");
}
__device__ __forceinline__ void norm_rows(const Frame& F, const float* X, const float* gain, bf16_t* Hout) {
    const int gw = F.vcu * NWAVES + F.wave, NGW = F.G * NWAVES;
    f32x4 gv[8];
#pragma unroll
    for (int j = 0; j < 8; ++j) gv[j] = *((const GAS f32x4*)gain + F.lane + 64 * j);
    for (int row = gw; row < T; row += NGW) {
        const GAS f32x4* xr = (const GAS f32x4*)(X + (size_t)row * DM) + F.lane;
        f32x4 v[8]; float s = 0.f;
#pragma unroll
        for (int j = 0; j < 8; ++j) { v[j] = xr[64 * j]; s += (v[j].x * v[j].x + v[j].y * v[j].y) + (v[j].z * v[j].z + v[j].w * v[j].w); }
        const float rstd = 1.0f / sqrtf(wave_sum(s) * (1.0f / DM) + EPS);
        GAS u32x2* o8 = (GAS u32x2*)(Hout + (size_t)row * DM) + F.lane;
#pragma unroll
        for (int j = 0; j < 8; ++j) { u32x2 w; w.x = cvt_pk_bf16(v[j].x * rstd * gv[j].x, v[j].y * rstd * gv[j].y); w.y = cvt_pk_bf16(v[j].z * rstd * gv[j].z, v[j].w * rstd * gv[j].w); o8[64 * j] = w; }
    }
}
__device__ __forceinline__ void norm_rows8(const Frame& F, const float* X, const float* gain, unsigned char* Hout) {
    const int gw = F.vcu * NWAVES + F.wave, NGW = F.G * NWAVES;
    f32x4 gv[8];
#pragma unroll
    for (int j = 0; j < 8; ++j) gv[j] = *((const GAS f32x4*)gain + F.lane + 64 * j);
    for (int row = gw; row < T; row += NGW) {
        const GAS f32x4* xr = (const GAS f32x4*)(X + (size_t)row * DM) + F.lane;
        f32x4 v[8]; float s = 0.f;
#pragma unroll
        for (int j = 0; j < 8; ++j) { v[j] = xr[64 * j]; s += (v[j].x * v[j].x + v[j].y * v[j].y) + (v[j].z * v[j].z + v[j].w * v[j].w); }
        const float rstd = 1.0f / sqrtf(wave_sum(s) * (1.0f / DM) + EPS);
        GAS unsigned* o4 = (GAS unsigned*)(Hout + (size_t)row * DM) + F.lane;
#pragma unroll
        for (int j = 0; j < 8; ++j) { const f32x4 hn = v[j] * rstd * gv[j]; o4[64 * j] = pk4_fp8(hn.x, hn.y, hn.z, hn.w, H8_SCALE); }
    }
}
__device__ __forceinline__ void norm_rows_i8(const Frame& F, const float* X, const float* gain, unsigned char* Hout) {
    const int gw = F.vcu * NWAVES + F.wave, NGW = F.G * NWAVES;
    f32x4 gv[8];
#pragma unroll
    for (int j = 0; j < 8; ++j) gv[j] = *((const GAS f32x4*)gain + F.lane + 64 * j);
    for (int row = gw; row < T; row += NGW) {
        const GAS f32x4* xr = (const GAS f32x4*)(X + (size_t)row * DM) + F.lane;
        f32x4 v[8]; float s = 0.f;
#pragma unroll
        for (int j = 0; j < 8; ++j) { v[j] = xr[64 * j]; s += (v[j].x * v[j].x + v[j].y * v[j].y) + (v[j].z * v[j].z + v[j].w * v[j].w); }
        const float rstd = 1.0f / sqrtf(wave_sum(s) * (1.0f / DM) + EPS);
        GAS unsigned* o4 = (GAS unsigned*)(Hout + (size_t)row * DM) + F.lane;
#pragma unroll
        for (int j = 0; j < 8; ++j) { const f32x4 hn = v[j] * rstd * gv[j]; o4[64 * j] = pk4_i8(hn.x, hn.y, hn.z, hn.w, HI8_SCALE); }
    }
}
__device__ __forceinline__ void norm_rows_i8b(const Frame& F, const bf16_t* X, const float* gain, unsigned char* Hout) {
    const int gw = F.vcu * NWAVES + F.wave, NGW = F.G * NWAVES;
    f32x4 gv[8];
#pragma unroll
    for (int j = 0; j < 8; ++j) gv[j] = *((const GAS f32x4*)gain + F.lane + 64 * j);
    for (int row = gw; row < T; row += NGW) {
        const GAS u32x2* xr = (const GAS u32x2*)(X + (size_t)row * DM) + F.lane;
        f32x4 v[8]; float s = 0.f;
#pragma unroll
        for (int j = 0; j < 8; ++j) { const u32x2 a = xr[64 * j]; v[j] = (f32x4){bf_lo(a.x), bf_hi(a.x), bf_lo(a.y), bf_hi(a.y)}; s += (v[j].x * v[j].x + v[j].y * v[j].y) + (v[j].z * v[j].z + v[j].w * v[j].w); }
        const float rstd = 1.0f / sqrtf(wave_sum(s) * (1.0f / DM) + EPS);
        GAS unsigned* o4 = (GAS unsigned*)(Hout + (size_t)row * DM) + F.lane;
#pragma unroll
        for (int j = 0; j < 8; ++j) { const f32x4 hn = v[j] * rstd * gv[j]; o4[64 * j] = pk4_i8(hn.x, hn.y, hn.z, hn.w, HI8_SCALE); }
    }
}
__device__ __forceinline__ void norm_rows_f32(const Frame& F, const float* X, const float* gain, float* out) {
    const int gw = F.vcu * NWAVES + F.wave, NGW = F.G * NWAVES;
    for (int row = gw; row < T; row += NGW) {
        const GAS f32x4* xr = (const GAS f32x4*)(X + (size_t)row * DM) + F.lane;
        f32x4 v[8]; float s = 0.f;
#pragma unroll
        for (int j = 0; j < 8; ++j) { v[j] = xr[64 * j]; s += (v[j].x * v[j].x + v[j].y * v[j].y) + (v[j].z * v[j].z + v[j].w * v[j].w); }
        const float rstd = 1.0f / sqrtf(wave_sum(s) * (1.0f / DM) + EPS);
        GAS f32x4* o = (GAS f32x4*)(out + (size_t)row * DM) + F.lane;
#pragma unroll
        for (int j = 0; j < 8; ++j) { const f32x4 gvv = *((const GAS f32x4*)gain + F.lane + 64 * j); o[64 * j] = v[j] * rstd * gvv; }
    }
}

struct Ptrs {
    const float *x, *ln_mix, *ln_ffn, *ln_final, *ret_w_in, *ret_w_out, *ffn_w_in, *ffn_w_out, *att_w_in, *att_w_out, *rel_bias, *router, *moe_w_in, *moe_w_out;
    float* out;
    bf16_t *W_RIN, *W_ROUT, *W_FIN, *W_FOUT, *W_AIN, *W_AOUT;
    unsigned char *W_MIN, *W_MOUT, *H8, *ACT2, *AG, *AO8, *AGC;
    bf16_t *H, *PROJ, *ACT, *QKV, *OB, *AO, *Y;
    bf16_t *X1, *X2, *X3; float* SSP; bf16_t* YB;
    int* LIST; unsigned* TOK;
};

constexpr int I_RIN = (DM / 64) * (NRET / 64), I_ROUT = (RHV / 64) * (DM / 64), I_FIN = (DM / 64) * (2 * FF / 64), I_FOUT = (FF / 64) * (DM / 64);
constexpr int I_AIN = (DM / 64) * (NATT / 64), I_AOUT = (DM / 64) * (DM / 64), I_MIN1 = (DM / 64) * (2 * FE / 64), I_MOUT1 = (FE / 64) * (DM / 64);
constexpr int NI_DENSE = I_RIN + I_ROUT + I_FIN + I_FOUT + I_AIN + I_AOUT, NITEMS = NI_DENSE + NE * I_MIN1 + NE * I_MOUT1;
constexpr int NI_SPLIT = I_RIN;
struct P0Item { const float* src; unsigned char* dst; int N, K, F, k0, n0, fp8; float sc; };
__device__ __forceinline__ P0Item p0_decode(const Ptrs& P, int it) {
    P0Item d; int r = it;
    if (r < I_RIN) { d.src = P.ret_w_in; d.dst = (unsigned char*)P.W_RIN; d.N = NRET; d.K = DM; d.F = 0; d.fp8 = I8_RIN ? 2 : 0; d.sc = I8_RIN ? WI8_SCALE : 1.f; }
    else if ((r -= I_RIN) < I_ROUT) { d.src = P.ret_w_out; d.dst = (unsigned char*)P.W_ROUT; d.N = DM; d.K = RHV; d.F = 0; d.fp8 = 0; d.sc = 1.f; }
    else if ((r -= I_ROUT) < I_FIN) { d.src = P.ffn_w_in; d.dst = (unsigned char*)P.W_FIN; d.N = 2 * FF; d.K = DM; d.F = FF; d.fp8 = 2; d.sc = WI8_SCALE; }
    else if ((r -= I_FIN) < I_FOUT) { d.src = P.ffn_w_out; d.dst = (unsigned char*)P.W_FOUT; d.N = DM; d.K = FF; d.F = 0; d.fp8 = F8_FOUT ? 1 : 0; d.sc = F8_FOUT ? W2_SCALE : 1.f; }
    else if ((r -= I_FOUT) < I_AIN) { d.src = P.att_w_in; d.dst = (unsigned char*)P.W_AIN; d.N = NATT; d.K = DM; d.F = 0; d.fp8 = I8_QKV ? 2 : 1; d.sc = I8_QKV ? WI8_SCALE : W1_SCALE; }
    else if ((r -= I_AIN) < I_AOUT) { d.src = P.att_w_out; d.dst = (unsigned char*)P.W_AOUT; d.N = DM; d.K = DM; d.F = 0; d.fp8 = 1; d.sc = W1_SCALE; }
    else if ((r -= I_AOUT) < NE * I_MIN1) { const int e = r / I_MIN1; r -= e * I_MIN1; d.src = P.moe_w_in + (size_t)e * DM * 2 * FE; d.dst = P.W_MIN + (size_t)e * 2 * FE * DM; d.N = 2 * FE; d.K = DM; d.F = FE; d.fp8 = I8_MOE ? 2 : 1; d.sc = I8_MOE ? WI8_SCALE : W1_SCALE; }
    else { r -= NE * I_MIN1; const int e = r / I_MOUT1; r -= e * I_MOUT1; d.src = P.moe_w_out + (size_t)e * FE * DM; d.dst = P.W_MOUT + (size_t)e * DM * FE; d.N = DM; d.K = FE; d.F = 0; d.fp8 = 1; d.sc = W2_SCALE; }
    const int nblk = d.N >> 6, kb = r / nblk, nb = r - kb * nblk; d.k0 = 64 * kb; d.n0 = 64 * nb;
    return d;
}
#define P0_LOAD(D, R) do { const float* s_ = (D).src + (size_t)((D).k0 + (lane >> 4)) * (D).N + (D).n0 + 4 * (lane & 15); \
        _Pragma("unroll") for (int i = 0; i < 16; ++i) R[i] = *(const GAS f32x4*)(s_ + (size_t)(4 * i) * (D).N); } while (0)
__device__ __forceinline__ void p0_process(const P0Item& d, const f32x4 (&v)[16], LAS float* scr, int lane) {
#pragma unroll
    for (int i = 0; i < 16; ++i) { LAS float* q = scr + (4 * i + (lane >> 4)) * 65 + 4 * (lane & 15); q[0] = v[i].x; q[1] = v[i].y; q[2] = v[i].z; q[3] = v[i].w; }
    LDS_WAIT(); asm volatile("" ::: "memory");
    if (d.fp8) { const int c = lane & 3;
#pragma unroll
        for (int j = 0; j < 4; ++j) { const int n = (lane >> 2) + 16 * j; const LAS float* s = scr + (16 * c) * 65 + n;
            u32x4 o;
            if (d.fp8 == 2) { o.x = pk4_i8(s[0 * 65], s[1 * 65], s[2 * 65], s[3 * 65], d.sc); o.y = pk4_i8(s[4 * 65], s[5 * 65], s[6 * 65], s[7 * 65], d.sc);
                o.z = pk4_i8(s[8 * 65], s[9 * 65], s[10 * 65], s[11 * 65], d.sc); o.w = pk4_i8(s[12 * 65], s[13 * 65], s[14 * 65], s[15 * 65], d.sc); }
            else { o.x = pk4_fp8(s[0 * 65], s[1 * 65], s[2 * 65], s[3 * 65], d.sc); o.y = pk4_fp8(s[4 * 65], s[5 * 65], s[6 * 65], s[7 * 65], d.sc);
                o.z = pk4_fp8(s[8 * 65], s[9 * 65], s[10 * 65], s[11 * 65], d.sc); o.w = pk4_fp8(s[12 * 65], s[13 * 65], s[14 * 65], s[15 * 65], d.sc); }
            *(GAS u32x4*)(d.dst + (size_t)dest_row(d.n0 + n, d.F) * d.K + d.k0 + 16 * c) = o; }
    } else { const int c = lane & 7;
#pragma unroll
        for (int j = 0; j < 8; ++j) { const int n = (lane >> 3) + 8 * j; const LAS float* s = scr + (8 * c) * 65 + n;
            u32x4 o; o.x = cvt_pk_bf16(s[0 * 65], s[1 * 65]); o.y = cvt_pk_bf16(s[2 * 65], s[3 * 65]); o.z = cvt_pk_bf16(s[4 * 65], s[5 * 65]); o.w = cvt_pk_bf16(s[6 * 65], s[7 * 65]);
            *(GAS u32x4*)((bf16_t*)d.dst + (size_t)dest_row(d.n0 + n, d.F) * d.K + d.k0 + 8 * c) = o; }
    }
    LDS_WAIT(); asm volatile("" ::: "memory");
}
__device__ __forceinline__ void cvt_items(const Frame& F, const Ptrs& P, int lo, int hi, int w, int nw) {
    LAS float* scr = (LAS float*)(F.lds + F.wave * 16640);
    const int lane = F.lane;
    f32x4 ra[16], rb[16];
    int it = lo + w;
    if (it < hi) { P0Item da = p0_decode(P, it); P0_LOAD(da, ra);
        for (;;) {
            const int i1 = it + nw; P0Item db = da; if (i1 < hi) { db = p0_decode(P, i1); P0_LOAD(db, rb); }
            p0_process(da, ra, scr, lane);
            if (i1 >= hi) break;
            const int i2 = i1 + nw; if (i2 < hi) { da = p0_decode(P, i2); P0_LOAD(da, ra); }
            p0_process(db, rb, scr, lane);
            if (i2 >= hi) break;
            it = i2;
        }
    }
}
__device__ __forceinline__ void p0_prologue(const Frame& F, const Ptrs& P) {
    cvt_items(F, P, 0, (F.G == 256) ? NI_SPLIT : NITEMS, F.vcu * NWAVES + F.wave, F.G * NWAVES);
    if (I8_RIN) norm_rows_i8(F, P.x, P.ln_mix, P.H8); else norm_rows(F, P.x, P.ln_mix, P.H);
}

__device__ __forceinline__ float row16_sum(float v) {
    v += __builtin_bit_cast(float, __builtin_amdgcn_update_dpp(0, __builtin_bit_cast(int, v), 0xB1, 0xf, 0xf, true));
    v += __builtin_bit_cast(float, __builtin_amdgcn_update_dpp(0, __builtin_bit_cast(int, v), 0x4E, 0xf, 0xf, true));
    v += __builtin_bit_cast(float, __builtin_amdgcn_update_dpp(0, __builtin_bit_cast(int, v), 0x141, 0xf, 0xf, true));
    v += __builtin_bit_cast(float, __builtin_amdgcn_update_dpp(0, __builtin_bit_cast(int, v), 0x140, 0xf, 0xf, true));
    return v;
}
__device__ __forceinline__ s16x4 lds_tr(LAS unsigned char* p) { return __builtin_amdgcn_ds_read_tr16_b64_v4i16((LAS s16x4*)p); }
__device__ __forceinline__ f32x4 mfma16(bf16x8 a, bf16x8 b, f32x4 c) { return __builtin_amdgcn_mfma_f32_16x16x32_bf16(a, b, c, 0, 0, 0); }
#define CAT8(lo, hi) ((bf16x8){(lo)[0], (lo)[1], (lo)[2], (lo)[3], (hi)[0], (hi)[1], (hi)[2], (hi)[3]})

__device__ __forceinline__ void retention_phase(const Frame& F, const Ptrs& P) {
    constexpr int QS = 0, KS = 33792, VS = 67584, SSO = 84992, SSW = 94208;
    constexpr int QST = 528, VST = 272, SST = 144;
    LAS unsigned char* L = F.lds;
    const int tid = F.tid, lane = F.lane, w = F.wave, c16 = lane & 15, g = lane >> 4, q4 = c16 >> 2, p4 = c16 & 3;
    const bool split = (F.G == 256);
    const int bx = (int)blockIdx.x, ridx = (bx >> 3) * 4 + ((bx & 7) >> 1);
    if (split && (bx & 1)) { cvt_items(F, P, NI_SPLIT, NITEMS, ridx * NWAVES + F.wave, 128 * NWAVES); return; }
    const int u0 = split ? ridx : bx, ustep = split ? 128 : F.G;
    for (int unit = u0; unit < NBATCH * RH * 4; unit += ustep) {
        const int b = unit >> 5, h = (unit >> 2) & 7, vs = unit & 3;
        const float xg = __builtin_amdgcn_exp2f(-(float)(5 + h));
        const float l2g = -(xg * (1.f + xg * (0.5f + xg * (1.f / 3.f + xg * (0.25f + xg * (0.2f + xg * (1.f / 6.f))))))) * LOG2E;
        const float cdec = __builtin_amdgcn_exp2f(l2g * 64.f);
        f32x4 st[16];
#pragma unroll
        for (int i = 0; i < 16; ++i) st[i] = (f32x4){0.f, 0.f, 0.f, 0.f};
        u32x4 rq[4], rk[4], rv[2];
        const unsigned lqk = (unsigned)((tid >> 5) * NRET + (tid & 31) * 8), lvv = (unsigned)((tid >> 4) * NRET + (tid & 15) * 8);
#define RET_LOAD(cc) do { const bf16_t* pb = P.PROJ + ((size_t)b * SEQ + (size_t)(cc) * CHUNK) * NRET; \
            _Pragma("unroll") for (int i = 0; i < 4; ++i) { const bf16_t* src = pb + (size_t)(16 * i) * NRET + h * RDK; \
                rq[i] = *(const GAS u32x4*)(src + lqk); rk[i] = *(const GAS u32x4*)(src + DM + lqk); } \
            _Pragma("unroll") for (int i = 0; i < 2; ++i) { const bf16_t* src = pb + (size_t)(32 * i) * NRET + 2 * DM + h * RDV + vs * 128; \
                rv[i] = *(const GAS u32x4*)(src + lvv); } } while (0)
        RET_LOAD(0);
        for (int c = 0; c < SEQ / CHUNK; ++c) {
            const size_t t0 = (size_t)b * SEQ + (size_t)c * CHUNK;
            __syncthreads();
            if (c > 0 && tid < 64) { float s = 0.f;
#pragma unroll
                for (int ww = 0; ww < 8; ++ww) s += *(LAS float*)(L + SSW + (ww * 64 + tid) * 4);
                P.SSP[(t0 - CHUNK + tid) * 32 + h * 4 + vs] = s; }
#pragma unroll
            for (int i = 0; i < 4; ++i) { const int ci = tid + 512 * i, row = ci >> 5, ch = ci & 31;
                *(LAS u32x4*)(L + QS + row * QST + ch * 16) = rq[i]; *(LAS u32x4*)(L + KS + row * QST + ch * 16) = rk[i]; }
#pragma unroll
            for (int i = 0; i < 2; ++i) { const int ci = tid + 512 * i, row = ci >> 4, ch = ci & 15; *(LAS u32x4*)(L + VS + row * VST + ch * 16) = rv[i]; }
            __syncthreads();
            if (c + 1 < SEQ / CHUNK) RET_LOAD(c + 1);
            float lg = l2g; int gq = 4 * g, cq = c16;
            asm volatile("" : "+v"(lg), "+v"(gq), "+v"(cq));
            {
                const int nt = w >> 1;
                f32x4 a4[2] = {(f32x4){0.f, 0.f, 0.f, 0.f}, (f32x4){0.f, 0.f, 0.f, 0.f}};
#pragma unroll
                for (int s = 0; s < 8; ++s) { const bf16x8 qb = *(const LAS bf16x8*)(L + QS + (16 * nt + c16) * QST + (32 * s + 8 * g) * 2);
#pragma unroll
                    for (int mi = 0; mi < 2; ++mi) { const int mt = 2 * (w & 1) + mi;
                        const bf16x8 ka = *(const LAS bf16x8*)(L + KS + (16 * mt + c16) * QST + (32 * s + 8 * g) * 2);
                        a4[mi] = mfma16(ka, qb, a4[mi]); } }
                const int n = 16 * nt + c16;
#pragma unroll
                for (int mi = 0; mi < 2; ++mi) { const int mt = 2 * (w & 1) + mi; const int nm = 16 * (nt - mt) + cq - gq;
#pragma unroll
                    for (int r = 0; r < 4; ++r) { const int d0 = nm - r; const int dd = d0 < 0 ? -d0 : d0; a4[mi][r] *= __builtin_amdgcn_exp2f(lg * (float)dd); }
                    u32x2 pk; pk.x = cvt_pk_bf16(a4[mi][0], a4[mi][1]); pk.y = cvt_pk_bf16(a4[mi][2], a4[mi][3]);
                    *(LAS u32x2*)(L + SSO + n * SST + (16 * mt + 4 * g) * 2) = pk; }
            }
            __syncthreads();
            f32x4 ac[4];
#pragma unroll
            for (int nt = 0; nt < 4; ++nt) ac[nt] = (f32x4){0.f, 0.f, 0.f, 0.f};
#pragma unroll
            for (int s = 0; s < 8; ++s) { u32x4 pw; pw.x = cvt_pk_bf16(st[2 * s][0], st[2 * s][1]); pw.y = cvt_pk_bf16(st[2 * s][2], st[2 * s][3]);
                pw.z = cvt_pk_bf16(st[2 * s + 1][0], st[2 * s + 1][1]); pw.w = cvt_pk_bf16(st[2 * s + 1][2], st[2 * s + 1][3]); const bf16x8 sbs = __builtin_bit_cast(bf16x8, pw);
#pragma unroll
                for (int nt = 0; nt < 4; ++nt) { const s16x4 lo = *(const LAS s16x4*)(L + QS + (16 * nt + c16) * QST + (32 * s + 4 * g) * 2);
                    const s16x4 hi = *(const LAS s16x4*)(L + QS + (16 * nt + c16) * QST + (32 * s + 16 + 4 * g) * 2);
                    ac[nt] = mfma16(CAT8(lo, hi), sbs, ac[nt]); }
                if (s & 1) __builtin_amdgcn_sched_barrier(0); }
#pragma unroll
            for (int nt = 0; nt < 4; ++nt)
#pragma unroll
                for (int r = 0; r < 4; ++r) ac[nt][r] *= __builtin_amdgcn_exp2f(fmaf(lg, (float)(16 * nt + r + 1), lg * (float)gq));
            bf16x8 vf[2];
#pragma unroll
            for (int s = 0; s < 2; ++s) { const s16x4 lo = lds_tr(L + VS + (32 * s + 8 * g + q4) * VST + (16 * w + 4 * p4) * 2);
                const s16x4 hi = lds_tr(L + VS + (32 * s + 8 * g + 4 + q4) * VST + (16 * w + 4 * p4) * 2);
                vf[s] = CAT8(lo, hi); }
#pragma unroll
            for (int s = 0; s < 2; ++s)
#pragma unroll
                for (int nt = 0; nt < 4; ++nt) { const bf16x8 sa = *(const LAS bf16x8*)(L + SSO + (16 * nt + c16) * SST + (32 * s + 8 * g) * 2); ac[nt] = mfma16(sa, vf[s], ac[nt]); }
            f32x4 sqv[4];
            const unsigned obo = (unsigned)(4 * g * RHV + c16);
#pragma unroll
            for (int nt = 0; nt < 4; ++nt) {
#pragma unroll
                for (int r = 0; r < 4; ++r) { const float o = ac[nt][r];
                    ((GAS bf16_t*)(P.OB + (t0 + 16 * nt + r) * RHV + h * RDV + vs * 128 + 16 * w))[obo] = (bf16_t)(cvt_pk_bf16(o, 0.f) & 0xffffu);
                    sqv[nt][r] = row16_sum(o * o); } }
            if (c16 == 0) {
#pragma unroll
                for (int nt = 0; nt < 4; ++nt) *(LAS f32x4*)(L + SSW + (w * 64 + 16 * nt + 4 * g) * 4) = sqv[nt]; }
            __builtin_amdgcn_sched_barrier(0);
            bf16x8 vd[2];
#pragma unroll
            for (int s = 0; s < 2; ++s) { float fv[8];
#pragma unroll
                for (int j = 0; j < 8; ++j) fv[j] = __uint_as_float(((unsigned)(unsigned short)vf[s][j]) << 16) * __builtin_amdgcn_exp2f(fmaf(lg, (float)(63 - 32 * s - j), -2.0f * lg * (float)gq));
                u32x4 pw; pw.x = cvt_pk_bf16(fv[0], fv[1]); pw.y = cvt_pk_bf16(fv[2], fv[3]); pw.z = cvt_pk_bf16(fv[4], fv[5]); pw.w = cvt_pk_bf16(fv[6], fv[7]);
                vd[s] = __builtin_bit_cast(bf16x8, pw); }
#pragma unroll
            for (int dt = 0; dt < 16; ++dt) { st[dt] = st[dt] * cdec;
#pragma unroll
                for (int s = 0; s < 2; ++s) { const s16x4 lo = lds_tr(L + KS + (32 * s + 8 * g + q4) * QST + (16 * dt + 4 * p4) * 2);
                    const s16x4 hi = lds_tr(L + KS + (32 * s + 8 * g + 4 + q4) * QST + (16 * dt + 4 * p4) * 2);
                    st[dt] = mfma16(CAT8(lo, hi), vd[s], st[dt]); }
                if (dt & 1) __builtin_amdgcn_sched_barrier(0); }
        }
#undef RET_LOAD
        __syncthreads();
        if (tid < 64) { float s = 0.f;
#pragma unroll
            for (int ww = 0; ww < 8; ++ww) s += *(LAS float*)(L + SSW + (ww * 64 + tid) * 4);
            P.SSP[((size_t)b * SEQ + SEQ - CHUNK + tid) * 32 + h * 4 + vs] = s; }
    }
}
__device__ __forceinline__ void gate_phase(const Frame& F, const Ptrs& P) {
    const int gw = F.vcu * NWAVES + F.wave, NGW = F.G * NWAVES;
    for (int row = gw; row < T; row += NGW) {
#pragma unroll
        for (int j = 0; j < 8; ++j) {
            const int idx = F.lane + 64 * j;
            const u32x4 ov = *((const GAS u32x4*)(P.OB + (size_t)row * RHV) + idx);
            const u32x4 gv = *((const GAS u32x4*)(P.PROJ + (size_t)row * NRET + 2 * DM + RHV) + idx);
            const f32x4 ss = *(const GAS f32x4*)(P.SSP + (size_t)row * 32 + 4 * j);
            const float rstd = 1.0f / sqrtf(((ss.x + ss.y) + (ss.z + ss.w)) * (1.0f / RDV) + EPS);
            u32x4 yo;
#define GATE1(W) cvt_pk_bf16(silu_f(bf_lo(gv.W)) * bf_lo(ov.W) * rstd, silu_f(bf_hi(gv.W)) * bf_hi(ov.W) * rstd)
            yo.x = GATE1(x); yo.y = GATE1(y); yo.z = GATE1(z); yo.w = GATE1(w);
#undef GATE1
            *((GAS u32x4*)(P.Y + (size_t)row * RHV) + idx) = yo;
        }
    }
}

__device__ __forceinline__ int crow(int r, int hi) { return (r & 3) + 8 * (r >> 2) + 4 * hi; }
#define KSWZ(row, colB) ((row) * 256 + ((colB) ^ (((row) & 7) << 4)))
__device__ __forceinline__ int v_st(int k, int c) { const int kk = (k & ~0xC) | ((k & 4) << 1) | ((k & 8) >> 1); return ((kk >> 3) * 4 + (c >> 5)) * 512 + ((kk & 7) * 32 + (c & 31)) * 2; }
__device__ __forceinline__ int v_rd_base(int lane) { return ((lane & 3) << 3) | (((lane >> 2) & 3) << 6) | (((lane >> 4) & 1) << 5) | (((lane >> 5) & 1) << 8); }
__device__ __forceinline__ f32x16 mfma32(bf16x8 a, bf16x8 b, f32x16 c) { return __builtin_amdgcn_mfma_f32_32x32x16_bf16(a, b, c, 0, 0, 0); }

__device__ __forceinline__ void attention_phase(const Frame& F, const Ptrs& P) {
    constexpr int VL = 0, KL = 32768, WSL = 65536, BL = 67584;
    constexpr float C = 0.08838834764831845f * LOG2E;
    LAS unsigned char* L = F.lds;
    const int tid = F.tid, lane = F.lane, w = F.wave, r32 = lane & 31, hi = lane >> 5;
    LAS float* al_l = (LAS float*)(L + WSL + w * 256); LAS float* li_l = al_l + 32;
    const int sr = tid >> 4, sc = (tid & 15) * 8, vst0 = v_st(sr, sc), vst1 = v_st(32 + sr, sc);
    const int vb = VL + v_rd_base(lane);
    for (int uj = blockIdx.x; uj < NBATCH * AH * 8 * ((DUP_MASK & 0x400) ? 2 : 1); uj += F.G) {
        const int ui = uj & (NBATCH * AH * 8 - 1);
        const int qb = ui >> 7, bh = ui & 127, b = bh >> 4, h = bh & 15;
        __syncthreads();
        if (tid < 257) *(LAS float*)(L + BL + tid * 4) = P.rel_bias[h * 257 + tid] * LOG2E;
        const size_t tq0 = (size_t)b * SEQ + (size_t)qb * 256;
        bf16x8 qr[8];
        { const bf16_t* Qw = P.QKV + (tq0 + 32 * w + r32) * NATT + h * AD + hi * 8;
#pragma unroll
          for (int d0 = 0; d0 < 8; ++d0) qr[d0] = *(const GAS bf16x8*)(Qw + d0 * 16); }
        const int kt_lo = (4 * qb - 8) > 0 ? (4 * qb - 8) : 0, kt_hi = 4 * qb + 3, cw = 4 * qb + (w >> 1), qrow = (w & 1) * 32 + r32;
        float m_reg = -1e30f, l_reg = 0.f; f32x16 o[4];
#pragma unroll
        for (int d = 0; d < 4; ++d)
#pragma unroll
            for (int r = 0; r < 16; ++r) o[d][r] = 0.f;
        u32x4 sk0, sk1, sv0, sv1;
#define ASLOAD(kt) do { const bf16_t* kp = P.QKV + ((size_t)b * SEQ + (size_t)(kt) * 64 + sr) * NATT + DM + h * AD + sc; \
        sk0 = *(const GAS u32x4*)(kp); sk1 = *(const GAS u32x4*)(kp + (size_t)32 * NATT); sv0 = *(const GAS u32x4*)(kp + DM); sv1 = *(const GAS u32x4*)(kp + (size_t)32 * NATT + DM); } while (0)
        ASLOAD(kt_lo);
        for (int kt = kt_lo; kt <= kt_hi; ++kt) {
            const int bo = (kt & 1) * 16384;
            *(LAS u32x4*)(L + VL + bo + vst0) = sv0; *(LAS u32x4*)(L + VL + bo + vst1) = sv1;
            *(LAS u32x4*)(L + KL + bo + KSWZ(sr, sc * 2)) = sk0; *(LAS u32x4*)(L + KL + bo + KSWZ(32 + sr, sc * 2)) = sk1;
            __syncthreads();
            if (kt < kt_hi) ASLOAD(kt + 1);
            const int delta = cw - kt;
            if (delta >= 0 && delta <= 8) {
                f32x16 p0, p1;
#pragma unroll
                for (int r = 0; r < 16; ++r) { p0[r] = 0.f; p1[r] = 0.f; }
#pragma unroll
                for (int d0 = 0; d0 < 8; ++d0) { const int cb = (d0 * 16 + hi * 8) * 2;
                    const bf16x8 k0 = *(const LAS bf16x8*)(L + KL + bo + KSWZ(r32, cb));
                    const bf16x8 k1 = *(const LAS bf16x8*)(L + KL + bo + KSWZ(32 + r32, cb));
                    p0 = mfma32(k0, qr[d0], p0); p1 = mfma32(k1, qr[d0], p1);
                    if ((d0 & 3) == 3) __builtin_amdgcn_sched_barrier(0); }
                if (delta >= 3) { const float bc = *(LAS float*)(L + BL + 256 * 4);
#pragma unroll
                    for (int r = 0; r < 16; ++r) { p0[r] = fmaf(p0[r], C, bc); p1[r] = fmaf(p1[r], C, bc); }
                } else { const int base = qrow + 64 * delta + 128 - 4 * hi;
#pragma unroll
                    for (int r = 0; r < 16; ++r) { int i0 = base - ((r & 3) + 8 * (r >> 2)); int i1 = i0 - 32; i0 = i0 > 256 ? 256 : i0; i1 = i1 > 256 ? 256 : i1;
                        p0[r] = fmaf(p0[r], C, *(LAS float*)(L + BL + i0 * 4)); p1[r] = fmaf(p1[r], C, *(LAS float*)(L + BL + i1 * 4)); }
                }
                float pmax = p0[0];
#pragma unroll
                for (int r = 1; r < 16; ++r) pmax = fmaxf(pmax, p0[r]);
#pragma unroll
                for (int r = 0; r < 16; ++r) pmax = fmaxf(pmax, p1[r]);
                { auto rr = __builtin_amdgcn_permlane32_swap(__float_as_uint(pmax), __float_as_uint(pmax), false, false); pmax = fmaxf(__uint_as_float(rr[0]), __uint_as_float(rr[1])); }
                const float mn = fmaxf(m_reg, pmax), alpha = __builtin_amdgcn_exp2f(m_reg - mn); m_reg = mn;
                float ps = 0.f;
#pragma unroll
                for (int r = 0; r < 16; ++r) { p0[r] = __builtin_amdgcn_exp2f(p0[r] - mn); p1[r] = __builtin_amdgcn_exp2f(p1[r] - mn); ps += p0[r] + p1[r]; }
                { auto rr = __builtin_amdgcn_permlane32_swap(__float_as_uint(ps), __float_as_uint(ps), false, false); ps = __uint_as_float(rr[0]) + __uint_as_float(rr[1]); }
                l_reg = l_reg * alpha + ps;
                if (__any(alpha != 1.0f)) {
                if (hi == 0) al_l[r32] = alpha;
                LDS_WAIT();
#pragma unroll
                for (int r = 0; r < 16; ++r) { const float a = al_l[crow(r, hi)];
#pragma unroll
                    for (int d = 0; d < 4; ++d) o[d][r] *= a; } }
                bf16x8 pa[4];
#define PK4(PP, BASE, OUT) do { unsigned a0 = cvt_pk_bf16(PP[BASE + 0], PP[BASE + 1]), a1 = cvt_pk_bf16(PP[BASE + 2], PP[BASE + 3]);   \
                    unsigned b0 = cvt_pk_bf16(PP[BASE + 4], PP[BASE + 5]), b1 = cvt_pk_bf16(PP[BASE + 6], PP[BASE + 7]);                          \
                    auto r0 = __builtin_amdgcn_permlane32_swap(a0, b0, false, false); auto r1 = __builtin_amdgcn_permlane32_swap(a1, b1, false, false); \
                    u32x4 ww = {r0[0], r1[0], r0[1], r1[1]}; OUT = __builtin_bit_cast(bf16x8, ww); } while (0)
                PK4(p0, 0, pa[0]); PK4(p0, 8, pa[1]); PK4(p1, 0, pa[2]); PK4(p1, 8, pa[3]);
#undef PK4
#pragma unroll
                for (int d0 = 0; d0 < 4; ++d0) {
#pragma unroll
                    for (int ks = 0; ks < 4; ++ks) { const s16x4 lo = lds_tr(L + bo + vb + d0 * 512 + ks * 4096); const s16x4 hh = lds_tr(L + bo + vb + d0 * 512 + ks * 4096 + 2048);
                        o[d0] = mfma32(pa[ks], CAT8(lo, hh), o[d0]); }
                    __builtin_amdgcn_sched_barrier(0); }
            }
        }
#undef ASLOAD
        if (hi == 0) li_l[r32] = l_reg;
        LDS_WAIT();
        unsigned char* Ow = P.AO8 + (tq0 + 32 * w) * DM + h * AD;
        const unsigned eo = (unsigned)(4 * hi * DM + r32);
#pragma unroll
        for (int r = 0; r < 16; ++r) { const int orow = crow(r, hi); const float rl = __builtin_amdgcn_rcpf(li_l[orow]);
            unsigned char* Or = Ow + (size_t)((r & 3) + 8 * (r >> 2)) * DM; const float rs = rl * H8_SCALE;
#pragma unroll
            for (int d0 = 0; d0 < 4; ++d0) Or[eo + d0 * 32] = (unsigned char)(__builtin_amdgcn_cvt_pk_fp8_f32(__builtin_amdgcn_fmed3f(o[d0][r] * rs, -448.f, 448.f), 0.f, 0, false) & 0xff);
            if ((r & 3) == 3) __builtin_amdgcn_sched_barrier(0); }
    }
}

__device__ __forceinline__ void router_phase(const Frame& F, const Ptrs& P) {
    LAS float* WR = (LAS float*)F.lds;
    LAS unsigned* RI = (LAS unsigned*)(F.lds + 65536);
    LAS unsigned* EC = (LAS unsigned*)(F.lds + 65536 + 2048);
    for (int i = F.tid; i < DM * NE / 4; i += NWAVES * 64) ((LAS f32x4*)WR)[i] = ((const GAS f32x4*)P.router)[i];
    const int gw = F.vcu * NWAVES + F.wave, NGW = F.G * NWAVES;
    const float* gain = P.ln_ffn + DM;
    f32x4 gvr[8];
#pragma unroll
    for (int j = 0; j < 8; ++j) gvr[j] = *((const GAS f32x4*)gain + F.lane + 64 * j);
    constexpr int RB = 4;
    for (int row0 = gw; row0 < T; row0 += RB * NGW) {
        if (F.tid < 16) EC[F.tid] = 0u;
        __syncthreads();
        unsigned rowpk[RB][8];
#pragma unroll
        for (int it = 0; it < RB; ++it) { const int row = row0 + it * NGW; const bool live = row < T; const int rr_ = live ? row : row0;
            const GAS u32x2* xr = (const GAS u32x2*)(P.X3 + (size_t)rr_ * DM) + F.lane;
            f32x4 v[8]; float s = 0.f;
#pragma unroll
            for (int j = 0; j < 8; ++j) { const u32x2 a = xr[64 * j]; v[j] = (f32x4){bf_lo(a.x), bf_hi(a.x), bf_lo(a.y), bf_hi(a.y)}; s += (v[j].x * v[j].x + v[j].y * v[j].y) + (v[j].z * v[j].z + v[j].w * v[j].w); }
            const float rstd = 1.0f / sqrtf(wave_sum(s) * (1.0f / DM) + EPS);
            float lg[8];
            int lz = F.lane; asm volatile("" : "+v"(lz));
#pragma unroll
            for (int e = 0; e < 8; ++e) lg[e] = 0.f;
#pragma unroll
            for (int j = 0; j < 8; ++j) { const f32x4 hn = v[j] * rstd * gvr[j];
                rowpk[it][j] = I8_MOE ? pk4_i8(hn.x, hn.y, hn.z, hn.w, HI8_SCALE) : pk4_fp8(hn.x, hn.y, hn.z, hn.w, H8_SCALE);
#pragma unroll
                for (int i = 0; i < 4; ++i) { const LAS f32x4* wp = (const LAS f32x4*)(WR + (4 * (lz + 64 * j) + i) * 8); const f32x4 w0 = wp[0], w1 = wp[1]; const float hv = hn[i];
                    lg[0] += hv * w0.x; lg[1] += hv * w0.y; lg[2] += hv * w0.z; lg[3] += hv * w0.w; lg[4] += hv * w1.x; lg[5] += hv * w1.y; lg[6] += hv * w1.z; lg[7] += hv * w1.w; } }
#pragma unroll
            for (int e = 0; e < 8; ++e) lg[e] = wave_sum(lg[e]);
            int i1 = 0; float v1 = lg[0];
#pragma unroll
            for (int e = 1; e < 8; ++e) if (lg[e] > v1) { v1 = lg[e]; i1 = e; }
            int i2 = -1; float v2 = -3.0e38f;
#pragma unroll
            for (int e = 0; e < 8; ++e) if (e != i1 && lg[e] > v2) { v2 = lg[e]; i2 = e; }
            if (F.lane == 0 && live) {
                const float g1 = 1.0f / (1.0f + __expf(v2 - v1)), g2 = 1.0f - g1;
                const unsigned r1 = __hip_atomic_fetch_add(EC + i1, 1u, __ATOMIC_RELAXED, __HIP_MEMORY_SCOPE_WORKGROUP);
                const unsigned r2 = __hip_atomic_fetch_add(EC + i2, 1u, __ATOMIC_RELAXED, __HIP_MEMORY_SCOPE_WORKGROUP);
                LAS unsigned* ri = RI + (F.wave * 8 + it) * 8;
                ri[0] = (unsigned)i1; ri[1] = r1; ri[2] = (unsigned)i2; ri[3] = r2; ri[4] = __float_as_uint(g1); ri[5] = __float_as_uint(g2);
            }
            asm volatile("" ::: "memory"); __builtin_amdgcn_sched_barrier(0);
        }
        __syncthreads();
        if (F.tid < 8) EC[8 + F.tid] = __hip_atomic_fetch_add(F.ctl + CW_CNT + 64 * F.tid, EC[F.tid], RLX_AGENT);
        __syncthreads();
#pragma unroll
        for (int it = 0; it < RB; ++it) { const int row = row0 + it * NGW;
            if (row < T) { const LAS unsigned* ri = RI + (F.wave * 8 + it) * 8;
                const unsigned i1 = ri[0], i2 = ri[2], p1 = EC[8 + i1] + ri[1], p2 = EC[8 + i2] + ri[3];
                GAS unsigned* d1 = (GAS unsigned*)(P.AGC + ((size_t)i1 * T + p1) * DM) + F.lane; GAS unsigned* d2 = (GAS unsigned*)(P.AGC + ((size_t)i2 * T + p2) * DM) + F.lane;
#pragma unroll
                for (int j = 0; j < 8; ++j) { d1[64 * j] = rowpk[it][j]; d2[64 * j] = rowpk[it][j]; }
                if (F.lane == 0) { u32x4 t4; t4.x = i1; t4.y = p1; t4.z = i2; t4.w = p2;
                    *(GAS u32x4*)(P.TOK + (size_t)row * 8) = t4;
                    u32x2 g2v; g2v.x = ri[4]; g2v.y = ri[5];
                    *(GAS u32x2*)(P.TOK + (size_t)row * 8 + 4) = g2v; } } }
        __syncthreads();
    }
}
__device__ __forceinline__ void moe_offsets(const Frame& F, int (&toff)[9], int (&cnt)[8]) {
    int acc = 0;
#pragma unroll
    for (int e = 0; e < 8; ++e) { cnt[e] = __builtin_amdgcn_readfirstlane((int)__hip_atomic_load(F.ctl + CW_CNT + 64 * e, RLX_AGENT)); toff[e] = acc; acc += (cnt[e] + 255) >> 8; }
    toff[8] = acc;
}
__device__ __forceinline__ void gather_phase(const Frame& F, const Ptrs& P) {
    int toff[9], cnt[8]; moe_offsets(F, toff, cnt);
    const int gw = F.vcu * NWAVES + F.wave, NGW = F.G * NWAVES, R = toff[8] * 256;
    for (int r = gw; r < R; r += NGW) {
        const int tile = r >> 8; int e = 0;
#pragma unroll
        for (int j = 1; j < 8; ++j) e += (tile >= toff[j]) ? 1 : 0;
        const int pos = r - toff[e] * 256;
        GAS u32x4* dst = (GAS u32x4*)(P.AG + (size_t)r * DM) + F.lane;
        if (pos < cnt[e]) { const int src = P.LIST[(size_t)e * T + pos]; const GAS u32x4* sp = (const GAS u32x4*)(P.H8 + (size_t)src * DM) + F.lane;
#pragma unroll
            for (int j = 0; j < 2; ++j) dst[64 * j] = sp[64 * j];
        } else {
#pragma unroll
            for (int j = 0; j < 2; ++j) dst[64 * j] = (u32x4){0u, 0u, 0u, 0u};
        }
    }
}
__device__ __forceinline__ void final_phase(const Frame& F, const Ptrs& P) {
    int toff[9], cnt[8]; moe_offsets(F, toff, cnt);
    pg8::MoeTailOrder TO; TO.init(toff[8], DM / 256, FE / 2, F.G, 0);
    const size_t split_row = (size_t)TO.nMf * 256; const int nparts = TO.S;
    const int gw = F.vcu * NWAVES + F.wave, NGW = F.G * NWAVES;
    for (int row = gw; row < T; row += NGW) {
        const u32x4 t4 = *(const GAS u32x4*)(P.TOK + (size_t)row * 8); const u32x2 gg = *(const GAS u32x2*)(P.TOK + (size_t)row * 8 + 4);
        int o1 = 0, o2 = 0;
#pragma unroll
        for (int e = 0; e < 8; ++e) { o1 = ((int)t4.x == e) ? toff[e] : o1; o2 = ((int)t4.z == e) ? toff[e] : o2; }
        const size_t r1 = (size_t)o1 * 256 + t4.y, r2 = (size_t)o2 * 256 + t4.w; const float g1 = __uint_as_float(gg.x), g2 = __uint_as_float(gg.y);
        const GAS u32x2* xr = (const GAS u32x2*)(P.X3 + (size_t)row * DM) + F.lane;
        const GAS u32x2* y1 = (const GAS u32x2*)(P.YB + r1 * DM) + F.lane; const GAS u32x2* y2 = (const GAS u32x2*)(P.YB + r2 * DM) + F.lane;
        f32x4 v[8]; float s = 0.f;
#pragma unroll
        for (int j = 0; j < 8; ++j) { const u32x2 a = y1[64 * j], b = y2[64 * j];
            const f32x4 ya = (f32x4){bf_lo(a.x), bf_hi(a.x), bf_lo(a.y), bf_hi(a.y)}, yb = (f32x4){bf_lo(b.x), bf_hi(b.x), bf_lo(b.y), bf_hi(b.y)};
            const u32x2 xa = xr[64 * j];
            v[j] = (f32x4){bf_lo(xa.x), bf_hi(xa.x), bf_lo(xa.y), bf_hi(xa.y)} + (ya * g1 + yb * g2); }
        if (nparts > 1 && (r1 >= split_row || r2 >= split_row)) {
            for (int p = 1; p < nparts; ++p) { const float h1 = (r1 >= split_row) ? g1 : 0.f, h2 = (r2 >= split_row) ? g2 : 0.f;
                const GAS u32x2* z1 = y1 + ((r1 >= split_row) ? (size_t)p * MOE_ROWS * DM / 4 : 0); const GAS u32x2* z2 = y2 + ((r2 >= split_row) ? (size_t)p * MOE_ROWS * DM / 4 : 0);
#pragma unroll
                for (int j = 0; j < 8; ++j) { const u32x2 a = z1[64 * j], b = z2[64 * j];
                    const f32x4 ya = (f32x4){bf_lo(a.x), bf_hi(a.x), bf_lo(a.y), bf_hi(a.y)}, yb = (f32x4){bf_lo(b.x), bf_hi(b.x), bf_lo(b.y), bf_hi(b.y)};
                    v[j] = v[j] + (ya * h1 + yb * h2); } } }
#pragma unroll
        for (int j = 0; j < 8; ++j) { s += (v[j].x * v[j].x + v[j].y * v[j].y) + (v[j].z * v[j].z + v[j].w * v[j].w); }
        const float rstd = 1.0f / sqrtf(wave_sum(s) * (1.0f / DM) + EPS);
        GAS f32x4* o = (GAS f32x4*)(P.out + (size_t)row * DM) + F.lane;
#pragma unroll
        for (int j = 0; j < 8; ++j) { const f32x4 gvv = *((const GAS f32x4*)P.ln_final + F.lane + 64 * j); o[64 * j] = v[j] * rstd * gvv; }
    }
}

constexpr int N_PHASES = 17;
struct Args { const float* in[14]; float* out; unsigned char* ws; int ph_lo, ph_hi; };
__global__ void __launch_bounds__(NWAVES * 64, 2) trunk_fwd(Args args) {
    extern __shared__ __attribute__((aligned(16))) unsigned char lds[];
#define PHASE_SETUP() Frame F; Ptrs P; { int t_ = wave0 * 64 + (int)__builtin_amdgcn_mbcnt_hi(~0u, __builtin_amdgcn_mbcnt_lo(~0u, 0u)); asm volatile("" : "+v"(t_)); \
    unsigned char* ws = args.ws; asm volatile("" : "+s"(ws)); \
    F.lds = (LAS unsigned char*)lds; F.tid = t_; F.lane = t_ & 63; F.wave = __builtin_amdgcn_readfirstlane(t_ >> 6); \
    F.G = gridDim.x; { const int bx = blockIdx.x; F.vcu = (F.G % 8 == 0) ? (bx % 8) * (F.G / 8) + bx / 8 : bx; } \
    F.ctl = (unsigned*)(ws + WS_CTL); \
    P.x = args.in[0]; P.ln_mix = args.in[1]; P.ln_ffn = args.in[2]; P.ln_final = args.in[3]; P.ret_w_in = args.in[4]; P.ret_w_out = args.in[5]; P.ffn_w_in = args.in[6]; P.ffn_w_out = args.in[7]; \
    P.att_w_in = args.in[8]; P.att_w_out = args.in[9]; P.rel_bias = args.in[10]; P.router = args.in[11]; P.moe_w_in = args.in[12]; P.moe_w_out = args.in[13]; P.out = args.out; \
    P.W_RIN = (bf16_t*)(ws + WS_W_RIN); P.W_ROUT = (bf16_t*)(ws + WS_W_ROUT); P.W_FIN = (bf16_t*)(ws + WS_W_FIN); P.W_FOUT = (bf16_t*)(ws + WS_W_FOUT); \
    P.W_AIN = (bf16_t*)(ws + WS_W_AIN); P.W_AOUT = (bf16_t*)(ws + WS_W_AOUT); P.W_MIN = ws + WS_W_MIN; P.W_MOUT = ws + WS_W_MOUT; \
    P.H = (bf16_t*)(ws + WS_H); P.PROJ = (bf16_t*)(ws + WS_A); P.ACT = (bf16_t*)(ws + WS_A); P.QKV = (bf16_t*)(ws + WS_A); P.ACT2 = ws + WS_A; P.H8 = ws + WS_H; \
    P.OB = (bf16_t*)(ws + WS_B); P.AO = (bf16_t*)(ws + WS_B); P.AO8 = ws + WS_B; P.AG = ws + WS_B; P.AGC = ws + WS_AGC; P.Y = (bf16_t*)(ws + WS_Y); \
    P.X1 = (bf16_t*)(ws + WS_X1); P.X2 = (bf16_t*)(ws + WS_X2); P.X3 = (bf16_t*)(ws + WS_X3); P.YB = (bf16_t*)(ws + WS_YB); P.SSP = (float*)(ws + WS_SSP); \
    P.LIST = (int*)(ws + WS_LIST); P.TOK = (unsigned*)(ws + WS_TOK); }
    LAS unsigned char* const lds3 = (LAS unsigned char*)lds;
    const int wave0 = __builtin_amdgcn_readfirstlane((int)threadIdx.x >> 6);
    unsigned* const ctl0 = (unsigned*)(args.ws + WS_CTL);
    for (int u = threadIdx.x; u < (LDS_BYTES - LDSCTL_OFF) / 4; u += NWAVES * 64) ((LAS unsigned*)(lds3 + LDSCTL_OFF))[u] = 0u;
    __syncthreads();
    volatile LAS unsigned* MISC = (volatile LAS unsigned*)(lds3 + MISC_OFF);
    XcdBarrier bar; bar.bar = ctl0 + CW_BAR; bar.x = 0; bar.st = nullptr;
    if (!MK_PER_PHASE) bar = xcd_barrier_post(ctl0 + CW_BAR, MISC + 8);
    const int lo = args.ph_lo, hi = args.ph_hi;
#ifndef PH_MASK
#define PH_MASK 0x1ffff
#endif
#define IN(k) (((PH_MASK >> (k)) & 1) && lo <= (k) && (k) < hi)
#define SEAM(k) do { if (IN(k) && IN((k) + 1)) xcd_barrier(bar); } while (0)

    if (IN(0)) { PHASE_SETUP(); LAS unsigned char* ring = F.lds; (void)ring; p0_prologue(F, P); if (DUP_MASK & 1) p0_prologue(F, P); } SEAM(0);
#if DBG_STAGE >= 1
    if (IN(1)) { PHASE_SETUP(); LAS unsigned char* ring = F.lds; (void)ring;
#if I8_RIN
        pg8::Gemm g{(const bf16_t*)P.H8, P.W_RIN, T, NRET, DM / 2, 0u, 0u, 0u}; pg8::StaticOrder S; S.init(T, NRET, DM / 2, F.G, (int)blockIdx.x); pg8::EpiRetInT<true> E{P.PROJ, NRET, I8_DESCALE};
        pg8::gemm_phase<pg8::EpiRetInT<true>, pg8::StaticOrder, true, true, false, true>(ring, F.tid, g, S, E);
#else
        pg8::Gemm g{P.H, P.W_RIN, T, NRET, DM, 0u, 0u, 0u}; pg8::StaticOrder S; S.init(T, NRET, DM, F.G, (int)blockIdx.x); pg8::EpiRetIn E{P.PROJ, NRET, 0.f};
        pg8::gemm_phase<pg8::EpiRetIn, pg8::StaticOrder, true, true>(ring, F.tid, g, S, E);
#endif
    } SEAM(1);
    if (IN(2)) { PHASE_SETUP(); LAS unsigned char* ring = F.lds; (void)ring; retention_phase(F, P); if (DUP_MASK & 4) retention_phase(F, P); } SEAM(2);
    if (IN(3)) { PHASE_SETUP(); LAS unsigned char* ring = F.lds; (void)ring; gate_phase(F, P); if (DUP_MASK & 8) gate_phase(F, P); } SEAM(3);
    if (IN(4)) { PHASE_SETUP(); LAS unsigned char* ring = F.lds; (void)ring; pg8::Gemm g{P.Y, P.W_ROUT, T, DM, RHV, 0u, 0u, 0u}; pg8::StaticOrder S; S.init(T, DM, RHV, F.G, (int)blockIdx.x); pg8::EpiResB<false> E{P.x, P.X1, DM};
        pg8::gemm_phase<pg8::EpiResB<false>, pg8::StaticOrder, true, true>(ring, F.tid, g, S, E); } SEAM(4);
#endif
#if DBG_STAGE >= 2
    if (IN(5)) { PHASE_SETUP(); LAS unsigned char* ring = F.lds; (void)ring; norm_rows_i8b(F, P.X1, P.ln_ffn, P.H8); if (DUP_MASK & 32) norm_rows_i8b(F, P.X1, P.ln_ffn, P.H8); } SEAM(5);
    if (IN(6)) { PHASE_SETUP(); LAS unsigned char* ring = F.lds; (void)ring; pg8::Gemm g{(const bf16_t*)P.H8, P.W_FIN, T, 2 * FF, DM / 2, 0u, 0u, 0u}; pg8::StaticOrder S; S.init(T, 2 * FF, DM / 2, F.G, (int)blockIdx.x);
#if F8_FOUT
        pg8::EpiSwiglu8T<true> E{(unsigned char*)P.ACT, FF, A2_SCALE, I8_DESCALE};
        pg8::gemm_phase<pg8::EpiSwiglu8T<true>, pg8::StaticOrder, true, true, false, true>(ring, F.tid, g, S, E); } SEAM(6);
#else
        pg8::EpiSwigluI E{P.ACT, FF, I8_DESCALE};
        pg8::gemm_phase<pg8::EpiSwigluI, pg8::StaticOrder, true, true, false, true>(ring, F.tid, g, S, E); } SEAM(6);
#endif
#if F8_FOUT
    if (IN(7)) { PHASE_SETUP(); LAS unsigned char* ring = F.lds; (void)ring; pg8::Gemm g{P.ACT, P.W_FOUT, T, DM, FF / 2, SB_W2, SB_A2, SB_W2}; pg8::StaticOrder S; S.init(T, DM, FF / 2, F.G, (int)blockIdx.x); pg8::EpiResB<true> E{P.X1, P.X2, DM};
        pg8::gemm_phase<pg8::EpiResB<true>, pg8::StaticOrder, true, true, true>(ring, F.tid, g, S, E); } SEAM(7);
#else
    if (IN(7)) { PHASE_SETUP(); LAS unsigned char* ring = F.lds; (void)ring; pg8::Gemm g{P.ACT, P.W_FOUT, T, DM, FF, 0u, 0u, 0u}; pg8::StaticOrder S; S.init(T, DM, FF, F.G, (int)blockIdx.x); pg8::EpiResB<true> E{P.X1, P.X2, DM};
        pg8::gemm_phase<pg8::EpiResB<true>, pg8::StaticOrder, true, true>(ring, F.tid, g, S, E); } SEAM(7);
#endif
#endif
#if DBG_STAGE >= 3
    if (IN(8)) { PHASE_SETUP(); LAS unsigned char* ring = F.lds; (void)ring; norm_rows_i8b(F, P.X2, P.ln_mix + DM, P.H8); if (DUP_MASK & 256) norm_rows_i8b(F, P.X2, P.ln_mix + DM, P.H8); } SEAM(8);
    if (IN(9)) { PHASE_SETUP(); LAS unsigned char* ring = F.lds; (void)ring; pg8::Gemm g{(const bf16_t*)P.H8, P.W_AIN, T, NATT, DM / 2, SB_W1, SB_H8, SB_W1}; pg8::StaticOrder S; S.init(T, NATT, DM / 2, F.G, (int)blockIdx.x);
#if I8_QKV
        pg8::EpiBf16T<true> E{P.QKV, NATT, 0, I8_DESCALE};
        pg8::gemm_phase<pg8::EpiBf16T<true>, pg8::StaticOrder, true, true, false, true>(ring, F.tid, g, S, E);
#else
        pg8::EpiBf16 E{P.QKV, NATT, 0, 0.f};
        pg8::gemm_phase<pg8::EpiBf16, pg8::StaticOrder, true, true, true>(ring, F.tid, g, S, E);
#endif
    } SEAM(9);
    if (IN(10)) { PHASE_SETUP(); LAS unsigned char* ring = F.lds; (void)ring; attention_phase(F, P); if (DUP_MASK & 1024) attention_phase(F, P); } SEAM(10);
    if (IN(11)) { PHASE_SETUP(); LAS unsigned char* ring = F.lds; (void)ring; pg8::Gemm g{(const bf16_t*)P.AO8, P.W_AOUT, T, DM, DM / 2, SB_W1, SB_H8, SB_W1}; pg8::StaticOrder S; S.init(T, DM, DM / 2, F.G, (int)blockIdx.x); pg8::EpiResB<true> E{P.X2, P.X3, DM};
        pg8::gemm_phase<pg8::EpiResB<true>, pg8::StaticOrder, true, true, true>(ring, F.tid, g, S, E); } SEAM(11);
#endif
#if DBG_STAGE >= 100
    if (IN(12)) { PHASE_SETUP(); LAS unsigned char* ring = F.lds; (void)ring; router_phase(F, P); } SEAM(12);
    if (IN(13)) {   }
    if (IN(14)) { PHASE_SETUP(); LAS unsigned char* ring = F.lds; (void)ring; int toff[9], cnt[8]; moe_offsets(F, toff, cnt);
        pg8::MoeOrder S; S.nM = toff[8]; S.nN = 2 * FE / 256; S.nwg = S.nM * S.nN; S.G = F.G; S.c = (int)blockIdx.x; S.nt0 = (DM / 2) / 64; S.aseg = T; S.estride = (unsigned)(2 * FE * DM);
#pragma unroll
        for (int e = 0; e < 9; ++e) S.toff[e] = toff[e];
        pg8::Gemm g{(const bf16_t*)P.AGC, (const bf16_t*)P.W_MIN, toff[8] * 256, 2 * FE, DM / 2, SB_W1, SB_H8, SB_W1U};
#if I8_MOE
        pg8::EpiSwiglu8T<true> E{P.ACT2, FE, A2_SCALE, I8_DESCALE};
        pg8::gemm_phase<pg8::EpiSwiglu8T<true>, pg8::MoeOrder, true, true, false, true>(ring, F.tid, g, S, E);
#else
        pg8::EpiSwiglu8 E{P.ACT2, FE, 1.0f, 0.f};
        pg8::gemm_phase<pg8::EpiSwiglu8, pg8::MoeOrder, true, true, true>(ring, F.tid, g, S, E);
#endif
    } SEAM(14);
    if (IN(15)) { PHASE_SETUP(); LAS unsigned char* ring = F.lds; (void)ring; int toff[9], cnt[8]; moe_offsets(F, toff, cnt);
        pg8::MoeTailOrder S; S.init(toff[8], DM / 256, FE / 2, F.G, (int)blockIdx.x); S.estride = (unsigned)(DM * FE);
#pragma unroll
        for (int e = 0; e < 9; ++e) S.toff[e] = toff[e];
        pg8::Gemm g{(const bf16_t*)P.ACT2, (const bf16_t*)P.W_MOUT, toff[8] * 256, DM, FE / 2, SB_W2, SB_A2, SB_W2}; pg8::EpiBf16 E{P.YB, DM, (size_t)MOE_ROWS * DM, 0.f};
        pg8::gemm_phase<pg8::EpiBf16, pg8::MoeTailOrder, true, true, true>(ring, F.tid, g, S, E); } SEAM(15);
    if (IN(16)) { PHASE_SETUP(); LAS unsigned char* ring = F.lds; (void)ring; final_phase(F, P); if (DUP_MASK & 65536) final_phase(F, P); }
#else
    if (IN(16)) { PHASE_SETUP(); LAS unsigned char* ring = F.lds; (void)ring; norm_rows_f32(F, P.x, P.ln_final, P.out); }
#endif
#undef IN
#undef SEAM
}

extern "C" void kernel_launch(void* const* d_in, const int* in_sizes, int n_in, void* d_out, int out_size, void* d_ws, size_t ws_size, hipStream_t stream) {
    static int grid = 0;
    if (grid == 0) {
        if (n_in != 14 || in_sizes[0] != T * DM || out_size != T * DM || ws_size < WS_END) { fprintf(stderr, "kernel_launch: shape mismatch (n_in %d in0 %d out %d ws %zu, need ws >= %zu)\n", n_in, n_in > 0 ? in_sizes[0] : -1, out_size, ws_size, (size_t)WS_END); grid = -1; return; }
        int dev = 0, cus = 0, per_cu = 0;
        if (hipGetDevice(&dev) != hipSuccess || hipDeviceGetAttribute(&cus, hipDeviceAttributeMultiprocessorCount, dev) != hipSuccess) { fprintf(stderr, "kernel_launch: device query failed\n"); grid = -1; return; }
        if (hipFuncSetAttribute((const void*)trunk_fwd, hipFuncAttributeMaxDynamicSharedMemorySize, LDS_BYTES) != hipSuccess) { fprintf(stderr, "kernel_launch: hipFuncSetAttribute failed\n"); grid = -1; return; }
        if (hipOccupancyMaxActiveBlocksPerMultiprocessor(&per_cu, (const void*)trunk_fwd, NWAVES * 64, LDS_BYTES) != hipSuccess || per_cu < 1)
            fprintf(stderr, "kernel_launch: note: occupancy query reports %d workgroups per CU\n", per_cu);
        (void)hipGetLastError();
        grid = cus;
    }
    if (grid < 0) return;
    if (hipMemsetAsync((char*)d_ws + WS_CTL, 0, CTL_ZERO_BYTES, stream) != hipSuccess) { fprintf(stderr, "kernel_launch: memset failed\n"); return; }
    Args a{};
    for (int i = 0; i < 14; ++i) a.in[i] = (const float*)d_in[i];
    a.out = (float*)d_out; a.ws = (unsigned char*)d_ws;
#if MK_PER_PHASE
    for (int ph = 0; ph < N_PHASES; ++ph) { a.ph_lo = ph; a.ph_hi = ph + 1; hipLaunchKernelGGL(trunk_fwd, dim3(grid), dim3(NWAVES * 64), LDS_BYTES, stream, a); }
#else
    a.ph_lo = 0; a.ph_hi = N_PHASES;
    hipLaunchKernelGGL(trunk_fwd, dim3(grid), dim3(NWAVES * 64), LDS_BYTES, stream, a);
#endif
    const hipError_t le = hipPeekAtLastError();
    if (le != hipSuccess) fprintf(stderr, "kernel_launch: launch failed: %s\n", hipGetErrorName(le));
}
```

```cpp
#include <hip/hip_runtime.h>
#include <cstdio>
#include <cstdint>

#ifndef DBG_STAGE
#define DBG_STAGE 100
#endif
#ifndef DUP_MASK
#define EPI_DUP 0
#define DUP_MASK 0
#endif
#ifndef I8_MOE
#define I8_MOE 1
#endif
#ifndef I8_QKV
#define I8_QKV 1
#endif
#ifndef I8_RIN
#define F8_FOUT 1
#define I8_RIN 1
#endif
#ifndef MK_PER_PHASE
#define MK_PER_PHASE 0
#endif

#define GAS __attribute__((address_space(1)))
#define LAS __attribute__((address_space(3)))
typedef unsigned short bf16_t;
typedef short bf16x8 __attribute__((ext_vector_type(8)));
typedef short s16x4 __attribute__((ext_vector_type(4)));
typedef float f32x4 __attribute__((ext_vector_type(4)));
typedef float f32x16 __attribute__((ext_vector_type(16)));
typedef unsigned u32x4 __attribute__((ext_vector_type(4)));
typedef unsigned u32x2 __attribute__((ext_vector_type(2)));

constexpr int DM = 2048, NBATCH = 8, SEQ = 2048, T = NBATCH * SEQ, CHUNK = 64;
constexpr int RH = 8, RDK = 256, RDV = 512, RHV = RH * RDV, NRET = 2 * DM + 2 * RHV;
constexpr int AH = 16, AD = 128, NATT = 3 * DM;
constexpr int FF = 5632, NE = 8, FE = 7168;
constexpr int MOE_ROWS = 2 * T + NE * 256;
constexpr float EPS = 1e-6f;
constexpr float LOG2E = 1.4426950408889634f;
constexpr int NWAVES = 8;
constexpr float H8_SCALE = 32.f, W1_SCALE = 1024.f, A2_SCALE = 4.f, W2_SCALE = 2048.f;
constexpr float HI8_SCALE = 127.f / 4.f, WI8_SCALE = 127.f * 45.254833995939045f / 4.f, I8_DESCALE = 1.0f / (HI8_SCALE * WI8_SCALE);
constexpr unsigned SB_H8 = 0x7a7a7a7au  , SB_W1 = 0x75757575u  , SB_A2 = 0x7d7d7d7du  , SB_W2 = 0x74747474u  , SB_W1U = 0x77777777u  ;

constexpr size_t MiB = 1u << 20;
constexpr size_t WS_CTL = 0, CTL_ZERO_BYTES = 1 * MiB;
constexpr size_t WS_W_RIN = 2 * MiB, WS_W_ROUT = 50 * MiB, WS_W_FIN = 66 * MiB, WS_W_FOUT = 110 * MiB, WS_W_AIN = 132 * MiB, WS_W_AOUT = 156 * MiB;
constexpr size_t WS_W_MIN = 164 * MiB, WS_W_MOUT = 612 * MiB;
constexpr size_t WS_H = 836 * MiB;
constexpr size_t WS_A = 900 * MiB;
constexpr size_t WS_B = 1376 * MiB;
constexpr size_t WS_Y = 1512 * MiB;
constexpr size_t WS_X1 = 1640 * MiB, WS_X2 = 1768 * MiB, WS_X3 = 1896 * MiB;
constexpr size_t WS_YB = 2300 * MiB;
constexpr size_t WS_SSP = 2296 * MiB;
constexpr size_t WS_LIST = 2298 * MiB;
constexpr size_t WS_TOK = 2299 * MiB;
constexpr size_t WS_AGC = 2300 * MiB + 4 * 136 * MiB;
constexpr size_t WS_END = WS_AGC + 256 * MiB;
constexpr int CW_TMO = 0, CW_BAR = 4096, CW_CNT = 8192;

constexpr int RING_BYTES = 143360;
static_assert(8 * 16640 <= RING_BYTES && 131072 <= RING_BYTES, "phase scratch must stay below the LDS control words");
constexpr int LDSCTL_OFF = RING_BYTES, MISC_OFF = LDSCTL_OFF + 320;
constexpr int LDS_BYTES = 147456;

#define LDS_WAIT() asm volatile("s_waitcnt lgkmcnt(0)" ::: "memory")
#define VM_WAIT() asm volatile("s_waitcnt vmcnt(0)" ::: "memory")
#define RLX_AGENT __ATOMIC_RELAXED, __HIP_MEMORY_SCOPE_AGENT

__device__ __forceinline__ unsigned cvt_pk_bf16(float lo, float hi) { unsigned r; asm volatile("v_cvt_pk_bf16_f32 %0, %1, %2" : "=v"(r) : "v"(lo), "v"(hi)); return r; }
__device__ __forceinline__ float bf_lo(unsigned w) { return __uint_as_float(w << 16); }
__device__ __forceinline__ float bf_hi(unsigned w) { return __uint_as_float(w & 0xffff0000u); }
__device__ __forceinline__ float silu_f(float x) { return x * __builtin_amdgcn_rcpf(1.0f + __builtin_amdgcn_exp2f(-x * LOG2E)); }
__device__ __forceinline__ unsigned pk4_i8(float a, float b, float c, float d, float sc) {
    const int ia = (int)__builtin_rintf(__builtin_amdgcn_fmed3f(a * sc, -127.f, 127.f)), ib = (int)__builtin_rintf(__builtin_amdgcn_fmed3f(b * sc, -127.f, 127.f));
    const int ic = (int)__builtin_rintf(__builtin_amdgcn_fmed3f(c * sc, -127.f, 127.f)), id = (int)__builtin_rintf(__builtin_amdgcn_fmed3f(d * sc, -127.f, 127.f));
    return ((unsigned)ia & 0xffu) | (((unsigned)ib & 0xffu) << 8) | (((unsigned)ic & 0xffu) << 16) | ((unsigned)id << 24);
}
__device__ __forceinline__ float wave_sum(float v) {
    v += __builtin_bit_cast(float, __builtin_amdgcn_update_dpp(0, __builtin_bit_cast(int, v), 0xB1, 0xf, 0xf, true));
    v += __builtin_bit_cast(float, __builtin_amdgcn_update_dpp(0, __builtin_bit_cast(int, v), 0x4E, 0xf, 0xf, true));
    v += __builtin_bit_cast(float, __builtin_amdgcn_update_dpp(0, __builtin_bit_cast(int, v), 0x141, 0xf, 0xf, true));
    v += __builtin_bit_cast(float, __builtin_amdgcn_update_dpp(0, __builtin_bit_cast(int, v), 0x140, 0xf, 0xf, true));
    const int vi = __builtin_bit_cast(int, v);
    return (__builtin_bit_cast(float, __builtin_amdgcn_readlane(vi, 0)) + __builtin_bit_cast(float, __builtin_amdgcn_readlane(vi, 16)))
         + (__builtin_bit_cast(float, __builtin_amdgcn_readlane(vi, 32)) + __builtin_bit_cast(float, __builtin_amdgcn_readlane(vi, 48)));
}

namespace pg8 {
typedef int v4i32 __attribute__((ext_vector_type(4)));
constexpr int BM = 256, BK = 64, HALF = 128, HTB = HALF * BK * 2, STAGE_BYTES = 8 * HTB, NXCD = 8, WGM = 4;
__host__ __device__ __forceinline__ int lds_byte(int r, int c) { const int st = (r >> 4) * 2 + (c >> 5), rr = r & 15, cc = c & 31, ob = rr * 64 + cc * 2; return st * 1024 + (ob ^ (((ob >> 9) & 1) << 5)); }
__host__ __device__ __forceinline__ void stage_rc(int b, int& R, int& C) { const int st = b / 1024, sb = b % 1024, swz = sb ^ (((sb >> 9) & 1) << 5); R = (st >> 1) * 16 + swz / 64; C = (st & 1) * 32 + (swz % 64) / 2; }
__host__ __device__ __forceinline__ int perm32(int rho) { const int n = rho >> 4, i = rho & 15; return 8 * (i >> 2) + 4 * n + (i & 3); }

struct Unit { int pm, pn; unsigned boff; unsigned koff; int nt, part, arow; };
struct Gemm { const bf16_t* A; const bf16_t* Bt; int M, N, K; unsigned sW, sA, sWu; };

struct StaticOrder {
    int nM, nN, nwg, G, c, nt0;
    __device__ __forceinline__ void init(int M, int N, int K, int G_, int c_) { nM = M / BM; nN = N / BM; nwg = nM * nN; G = G_; c = c_; nt0 = K / BK; }
    __device__ __forceinline__ bool next(int i, Unit& u) const {
        const long L = (long)i * G + c; if (L >= nwg) return false;
        int wgid = (int)L; { const int q = nwg / NXCD, r = nwg % NXCD, xcd = wgid % NXCD, off = wgid / NXCD; wgid = (xcd < r ? xcd * (q + 1) : r * (q + 1) + (xcd - r) * q) + off; }
        const int nig = WGM * nN, gid = wgid / nig, fm = gid * WGM, gsz = (nM - fm) < WGM ? (nM - fm) : WGM;
        u.pm = fm + ((wgid % nig) % gsz); u.pn = (wgid % nig) / gsz; u.boff = 0; u.koff = 0; u.nt = nt0; u.part = 0; u.arow = u.pm * BM; return true;
    }
    __device__ __forceinline__ void a_ready(const Unit&) const {}
    __device__ __forceinline__ void done(const Unit&) const {}
};
struct MoeOrder {
    int nM, nN, nwg, G, c, nt0, aseg; int toff[9]; unsigned estride;
    __device__ __forceinline__ bool next(int i, Unit& u) const {
        const long L = (long)i * G + c; if (L >= nwg) return false;
        int wgid = (int)L; { const int q = nwg / NXCD, r = nwg % NXCD, xcd = wgid % NXCD, off = wgid / NXCD; wgid = (xcd < r ? xcd * (q + 1) : r * (q + 1) + (xcd - r) * q) + off; }
        const int CG = nN / NXCD, nig = CG * nM, gid = wgid / nig, fn = gid * CG;
        u.pn = fn + ((wgid % nig) % CG); u.pm = (wgid % nig) / CG;
        int e = 0;
#pragma unroll
        for (int j = 1; j < 8; ++j) e += (u.pm >= toff[j]) ? 1 : 0;
        u.boff = (unsigned)e * estride; u.koff = 0; u.nt = nt0; u.part = 0; { int te = 0;
#pragma unroll
          for (int j = 1; j < 8; ++j) te = (u.pm >= toff[j]) ? toff[j] : te;
          u.arow = e * aseg + (u.pm - te) * BM; } return true;
    }
    __device__ __forceinline__ void a_ready(const Unit&) const {}
    __device__ __forceinline__ void done(const Unit&) const {}
};

struct MoeTailOrder {
    int nM, nMf, nN, G, c, nt0, S; int toff[9]; unsigned estride;
    __device__ __forceinline__ void init(int nM_, int nN_, int K, int G_, int c_) { nM = nM_; nN = nN_; G = G_; c = c_; nt0 = K / BK;
        const int nwg = nM * nN, rem = nwg % G; S = (rem == 0 || rem * 2 > G) ? 1 : (rem * 4 > G ? 2 : 4); nMf = (S == 1) ? nM : nM - rem / nN; }
    __device__ __forceinline__ bool next(int i, Unit& u) const {
        const int nfull = nMf * nN; const int L = i * G + c;
        int pm, pn, nt, part; unsigned koff;
        if (L < nfull) {
            int wgid = L; { const int q = nfull / NXCD, r = nfull % NXCD, xcd = wgid % NXCD, off = wgid / NXCD; wgid = (xcd < r ? xcd * (q + 1) : r * (q + 1) + (xcd - r) * q) + off; }
            const int nig = WGM * nN, gid = wgid / nig, fm = gid * WGM, gsz = (nMf - fm) < WGM ? (nMf - fm) : WGM;
            pm = fm + ((wgid % nig) % gsz); pn = (wgid % nig) / gsz; koff = 0u; nt = nt0; part = 0;
        } else {
            const int j = L - nfull, ntail = (nM - nMf) * nN;
            if (j >= ntail * S) return false;
            const int tu = j / S, p = j - tu * S;
            pm = nMf + tu / nN; pn = tu % nN; nt = nt0 / S; koff = (unsigned)(p * nt * BK * 2); part = p;
        }
        int e = 0;
        e += (pm >= toff[1]) ? 1 : 0; e += (pm >= toff[2]) ? 1 : 0; e += (pm >= toff[3]) ? 1 : 0; e += (pm >= toff[4]) ? 1 : 0; e += (pm >= toff[5]) ? 1 : 0; e += (pm >= toff[6]) ? 1 : 0; e += (pm >= toff[7]) ? 1 : 0;
        u.pm = pm; u.pn = pn; u.boff = (unsigned)e * estride; u.koff = koff; u.nt = nt; u.part = part; u.arow = pm * BM; return true;
    }
    __device__ __forceinline__ void a_ready(const Unit&) const {}
    __device__ __forceinline__ void done(const Unit&) const {}
};
template <bool INT> __device__ __forceinline__ f32x4 accv(const f32x4& a, float dsc) { if constexpr (INT) return __builtin_convertvector(__builtin_bit_cast(v4i32, a), f32x4) * dsc; else return a; }
template <bool INT> struct EpiBf16T {
    static constexpr bool PERM = true, AFTER_DRAIN = false;
    bf16_t* O; int ldc; size_t pstride; float dsc;
    __device__ __forceinline__ void operator()(const f32x4 (&acc)[2][2][4][2], const Unit& u, int wr, int wc, int fr, int fq) const {
        const unsigned lo = (unsigned)((wr * 64 + fr) * ldc + u.pn * BM + wc * 32 + 8 * fq);
#pragma unroll
        for (int ai = 0; ai < 2; ++ai)
#pragma unroll
            for (int m = 0; m < 4; ++m) { bf16_t* rb = O + (size_t)u.part * pstride + (size_t)(u.pm * BM + ai * HALF + m * 16) * ldc;
#pragma unroll
                for (int bj = 0; bj < 2; ++bj) { const f32x4 v0 = accv<INT>(acc[ai][bj][m][0], dsc), v1 = accv<INT>(acc[ai][bj][m][1], dsc);
                    u32x4 w; w.x = cvt_pk_bf16(v0[0], v0[1]); w.y = cvt_pk_bf16(v0[2], v0[3]); w.z = cvt_pk_bf16(v1[0], v1[1]); w.w = cvt_pk_bf16(v1[2], v1[3]);
                    *(u32x4*)(rb + lo + bj * HALF) = w; } }
    }
};
typedef EpiBf16T<false> EpiBf16;
template <bool INT> struct EpiRetInT {
    static constexpr bool PERM = true, AFTER_DRAIN = false;
    bf16_t* O; int ldc; float dsc;
    __device__ __forceinline__ void operator()(const f32x4 (&acc)[2][2][4][2], const Unit& u, int wr, int wc, int fr, int fq) const {
        const int row0 = u.pm * BM + wr * 64 + fr;
        const unsigned lo = (unsigned)((wr * 64 + fr) * ldc + u.pn * BM + wc * 32 + 8 * fq);
        if (u.pn < 16) {
            const float ksc = (u.pn >= 8) ? 0.0625f : 1.0f;
            float rf[2][4];
#pragma unroll
            for (int n = 0; n < 2; ++n)
#pragma unroll
                for (int e = 0; e < 4; ++e) { const float d = (float)(wc * 32 + 8 * fq + 4 * n + e);
                    rf[n][e] = __builtin_amdgcn_exp2f(d * (-13.287712379549449f / 128.0f)) * 0.15915494309189535f; }
#pragma unroll
            for (int ai = 0; ai < 2; ++ai)
#pragma unroll
                for (int m = 0; m < 4; ++m) { const int row = row0 + ai * HALF + m * 16; const float pos = (float)(row & (SEQ - 1));
                    bf16_t* rowp = O + (size_t)(u.pm * BM + ai * HALF + m * 16) * ldc + lo;
                    f32x4 o1[2], o2[2];
#pragma unroll
                    for (int n = 0; n < 2; ++n) { const f32x4 x1 = accv<INT>(acc[ai][0][m][n], dsc), x2 = accv<INT>(acc[ai][1][m][n], dsc);
#pragma unroll
                        for (int e = 0; e < 4; ++e) { const float ph = __builtin_amdgcn_fractf(pos * rf[n][e]);
                            const float sn = __builtin_amdgcn_sinf(ph), cs = __builtin_amdgcn_cosf(ph);
                            o1[n][e] = (x1[e] * cs - x2[e] * sn) * ksc; o2[n][e] = (x1[e] * sn + x2[e] * cs) * ksc; } }
                    u32x4 w; w.x = cvt_pk_bf16(o1[0][0], o1[0][1]); w.y = cvt_pk_bf16(o1[0][2], o1[0][3]); w.z = cvt_pk_bf16(o1[1][0], o1[1][1]); w.w = cvt_pk_bf16(o1[1][2], o1[1][3]);
                    *(u32x4*)(rowp) = w;
                    w.x = cvt_pk_bf16(o2[0][0], o2[0][1]); w.y = cvt_pk_bf16(o2[0][2], o2[0][3]); w.z = cvt_pk_bf16(o2[1][0], o2[1][1]); w.w = cvt_pk_bf16(o2[1][2], o2[1][3]);
                    *(u32x4*)(rowp + HALF) = w; }
        } else {
#pragma unroll
            for (int ai = 0; ai < 2; ++ai)
#pragma unroll
                for (int m = 0; m < 4; ++m) { bf16_t* rb = O + (size_t)(u.pm * BM + ai * HALF + m * 16) * ldc;
#pragma unroll
                    for (int bj = 0; bj < 2; ++bj) { const f32x4 v0 = accv<INT>(acc[ai][bj][m][0], dsc), v1 = accv<INT>(acc[ai][bj][m][1], dsc);
                        u32x4 w; w.x = cvt_pk_bf16(v0[0], v0[1]); w.y = cvt_pk_bf16(v0[2], v0[3]); w.z = cvt_pk_bf16(v1[0], v1[1]); w.w = cvt_pk_bf16(v1[2], v1[3]);
                        *(u32x4*)(rb + lo + bj * HALF) = w; } }
        }
    }
};
typedef EpiRetInT<false> EpiRetIn;
struct EpiSwiglu {
    static constexpr bool PERM = true, AFTER_DRAIN = false;
    bf16_t* O; int ldc;
    __device__ __forceinline__ void operator()(const f32x4 (&acc)[2][2][4][2], const Unit& u, int wr, int wc, int fr, int fq) const {
        const unsigned lo = (unsigned)((wr * 64 + fr) * ldc + u.pn * HALF + wc * 32 + 8 * fq);
#pragma unroll
        for (int ai = 0; ai < 2; ++ai)
#pragma unroll
            for (int m = 0; m < 4; ++m) { bf16_t* rowp = O + (size_t)(u.pm * BM + ai * HALF + m * 16) * ldc + lo;
                f32x4 v[2];
#pragma unroll
                for (int n = 0; n < 2; ++n) { const f32x4 g = acc[ai][0][m][n], uu = acc[ai][1][m][n];
                    const f32x4 t = g * (-LOG2E); f32x4 d;
#pragma unroll
                    for (int e = 0; e < 4; ++e) d[e] = __builtin_amdgcn_exp2f(t[e]);
                    d = d + 1.0f;
#pragma unroll
                    for (int e = 0; e < 4; ++e) d[e] = __builtin_amdgcn_rcpf(d[e]);
                    v[n] = (g * uu) * d; }
                u32x4 w; w.x = cvt_pk_bf16(v[0][0], v[0][1]); w.y = cvt_pk_bf16(v[0][2], v[0][3]); w.z = cvt_pk_bf16(v[1][0], v[1][1]); w.w = cvt_pk_bf16(v[1][2], v[1][3]);
                *(u32x4*)(rowp) = w; }
    }
};
struct EpiSwigluI {
    static constexpr bool PERM = true, AFTER_DRAIN = false;
    bf16_t* O; int ldc; float dsc;
    __device__ __forceinline__ void operator()(const f32x4 (&acc)[2][2][4][2], const Unit& u, int wr, int wc, int fr, int fq) const {
        const unsigned lo = (unsigned)((wr * 64 + fr) * ldc + u.pn * HALF + wc * 32 + 8 * fq);
#pragma unroll
        for (int ai = 0; ai < 2; ++ai)
#pragma unroll
            for (int m = 0; m < 4; ++m) { bf16_t* rowp = O + (size_t)(u.pm * BM + ai * HALF + m * 16) * ldc + lo;
                f32x4 v[2];
#pragma unroll
                for (int n = 0; n < 2; ++n) { const f32x4 g = __builtin_convertvector(__builtin_bit_cast(v4i32, acc[ai][0][m][n]), f32x4), uu = __builtin_convertvector(__builtin_bit_cast(v4i32, acc[ai][1][m][n]), f32x4);
                    const f32x4 t = g * (-LOG2E * dsc); f32x4 d;
#pragma unroll
                    for (int e = 0; e < 4; ++e) d[e] = __builtin_amdgcn_exp2f(t[e]);
                    d = d + 1.0f;
#pragma unroll
                    for (int e = 0; e < 4; ++e) d[e] = __builtin_amdgcn_rcpf(d[e]);
                    v[n] = (g * uu) * (d * (dsc * dsc)); }
                u32x4 w; w.x = cvt_pk_bf16(v[0][0], v[0][1]); w.y = cvt_pk_bf16(v[0][2], v[0][3]); w.z = cvt_pk_bf16(v[1][0], v[1][1]); w.w = cvt_pk_bf16(v[1][2], v[1][3]);
                *(u32x4*)(rowp) = w; }
    }
};
template <bool INT> struct EpiSwiglu8T {
    static constexpr bool PERM = true, AFTER_DRAIN = false;
    unsigned char* O; int ldc; float oscale, dsc;
    __device__ __forceinline__ void operator()(const f32x4 (&acc)[2][2][4][2], const Unit& u, int wr, int wc, int fr, int fq) const {
        const unsigned lo = (unsigned)((wr * 64 + fr) * ldc + u.pn * HALF + wc * 32 + 8 * fq);
#pragma unroll
        for (int ai = 0; ai < 2; ++ai)
#pragma unroll
            for (int m = 0; m < 4; ++m) { unsigned char* rowp = O + (size_t)(u.pm * BM + ai * HALF + m * 16) * ldc + lo;
                f32x4 v[2];
#pragma unroll
                for (int n = 0; n < 2; ++n) {
                    const f32x4 g = INT ? __builtin_convertvector(__builtin_bit_cast(v4i32, acc[ai][0][m][n]), f32x4) : acc[ai][0][m][n];
                    const f32x4 uu = INT ? __builtin_convertvector(__builtin_bit_cast(v4i32, acc[ai][1][m][n]), f32x4) : acc[ai][1][m][n];
                    const float k1 = INT ? -LOG2E * dsc : -LOG2E, k2 = INT ? dsc * dsc * oscale : oscale;
                    const f32x4 t = g * k1; f32x4 d;
#pragma unroll
                    for (int e = 0; e < 4; ++e) d[e] = __builtin_amdgcn_exp2f(t[e]);
                    d = d + 1.0f;
#pragma unroll
                    for (int e = 0; e < 4; ++e) d[e] = __builtin_amdgcn_rcpf(d[e]);
                    const f32x4 o = (g * uu) * (d * k2);
#pragma unroll
                    for (int e = 0; e < 4; ++e) v[n][e] = __builtin_amdgcn_fmed3f(o[e], -448.f, 448.f); }
                u32x2 w; int t = 0;
                t = __builtin_amdgcn_cvt_pk_fp8_f32(v[0][0], v[0][1], t, false); t = __builtin_amdgcn_cvt_pk_fp8_f32(v[0][2], v[0][3], t, true); w.x = (unsigned)t;
                t = __builtin_amdgcn_cvt_pk_fp8_f32(v[1][0], v[1][1], t, false); t = __builtin_amdgcn_cvt_pk_fp8_f32(v[1][2], v[1][3], t, true); w.y = (unsigned)t;
                *(u32x2*)(rowp) = w; }
    }
};
typedef EpiSwiglu8T<false> EpiSwiglu8;
struct EpiResF32 {
    static constexpr bool PERM = false, AFTER_DRAIN = false;
    const float* base; float* out; int ldc;
    __device__ __forceinline__ void operator()(const f32x4 (&acc)[2][2][4][2], const Unit& u, int wr, int wc, int fr, int fq) const {
        const unsigned lo = (unsigned)((wr * 64 + fr) * ldc + u.pn * BM + wc * 32 + 4 * fq);
#pragma unroll
        for (int ai = 0; ai < 2; ++ai)
#pragma unroll
            for (int m = 0; m < 4; ++m) { const size_t rg = (size_t)(u.pm * BM + ai * HALF + m * 16) * ldc;
#pragma unroll
                for (int bj = 0; bj < 2; ++bj)
#pragma unroll
                    for (int n = 0; n < 2; ++n) { f32x4 o = acc[ai][bj][m][n]; if (base) o = o + *(const f32x4*)(base + rg + lo + bj * HALF + n * 16);
                        *(f32x4*)(out + rg + lo + bj * HALF + n * 16) = o; } }
    }
};

template <bool BASE_BF16> struct EpiResB {
    static constexpr bool PERM = true, AFTER_DRAIN = false;
    const void* base; bf16_t* out; int ldc;
    __device__ __forceinline__ void operator()(const f32x4 (&acc)[2][2][4][2], const Unit& u, int wr, int wc, int fr, int fq) const {
        const unsigned lo = (unsigned)((wr * 64 + fr) * ldc + u.pn * BM + wc * 32 + 8 * fq);
#pragma unroll
        for (int ai = 0; ai < 2; ++ai)
#pragma unroll
            for (int m = 0; m < 4; ++m) { const size_t rg = (size_t)(u.pm * BM + ai * HALF + m * 16) * ldc;
#pragma unroll
                for (int bj = 0; bj < 2; ++bj) { f32x4 v0 = acc[ai][bj][m][0], v1 = acc[ai][bj][m][1];
                    if constexpr (BASE_BF16) { const u32x4 b = *(const u32x4*)((const bf16_t*)base + rg + lo + bj * HALF);
                        v0 = v0 + (f32x4){bf_lo(b.x), bf_hi(b.x), bf_lo(b.y), bf_hi(b.y)}; v1 = v1 + (f32x4){bf_lo(b.z), bf_hi(b.z), bf_lo(b.w), bf_hi(b.w)}; }
                    else { const float* bp = (const float*)base + rg + lo + bj * HALF; v0 = v0 + *(const f32x4*)bp; v1 = v1 + *(const f32x4*)(bp + 4); }
                    u32x4 w; w.x = cvt_pk_bf16(v0[0], v0[1]); w.y = cvt_pk_bf16(v0[2], v0[3]); w.z = cvt_pk_bf16(v1[0], v1[1]); w.w = cvt_pk_bf16(v1[2], v1[3]);
                    *(u32x4*)(out + rg + lo + bj * HALF) = w; } }
    }
};

typedef int v8i32 __attribute__((ext_vector_type(8)));
template <class Epi, class Sched, bool ALIGN_EPI = false, bool SP2 = false, bool F8 = false, bool I8 = false>
__device__ __forceinline__ void gemm_phase(LAS unsigned char* lds, const int tid, const Gemm g, const Sched& S, const Epi& E) {
    const int wid = __builtin_amdgcn_readfirstlane(tid >> 6), lane = tid & 63, wr = wid >> 2, wc = wid & 3, fr = lane & 15, fq = lane >> 4;
    const int K = g.K;
    unsigned voffA[2], voffB[2];
#pragma unroll
    for (int i = 0; i < 2; ++i) { int R, C; stage_rc(tid * 16 + i * 8192, R, C); const int Rb = Epi::PERM ? ((R & ~31) + perm32(R & 31)) : R;
        voffA[i] = (unsigned)(R * K + C) * 2u; voffB[i] = (unsigned)(Rb * K + C) * 2u; }
    const __amdgpu_buffer_rsrc_t rsA = __builtin_amdgcn_make_buffer_rsrc((void*)g.A, 0, 0xffffffff, 0x00020000);
    const __amdgpu_buffer_rsrc_t rsB = __builtin_amdgcn_make_buffer_rsrc((void*)g.Bt, 0, 0xffffffff, 0x00020000);
    const int kstep = BK * 2;
    const int hstep = HALF * K * 2;
    const int tstep = 2 * hstep;
    const unsigned ldsw = (unsigned)wid * 1024u;
    const int aoff = lds_byte(wr * 64 + fr, fq * 8), boff = lds_byte(wc * 32 + fr, fq * 8);
#define PG8_SA(b, h) (((b) * 2 + (h)) * HTB)
#define PG8_SB(b, h) ((4 + (b) * 2 + (h)) * HTB)
#define PG8_RS_voffA rsA
#define PG8_RS_voffB rsB
#define PG8_STAGE(bufoff, soff, voff) do { _Pragma("unroll") for (int _i = 0; _i < 2; ++_i) \
        __builtin_amdgcn_raw_ptr_buffer_load_lds(PG8_RS_##voff, (LAS void*)(lds + (bufoff) + ldsw + _i * 8192), 16, (int)(voff)[_i], (int)(soff), 0, 0); } while (0)
#define PG8_LD8(p) __builtin_bit_cast(v8i32, __builtin_shufflevector(*(const LAS u32x4*)(p), *(const LAS u32x4*)((p) + 1024), 0, 1, 2, 3, 4, 5, 6, 7))
#define PG8_LDA(dst, b, h) do { if constexpr (F8) { _Pragma("unroll") for (int m = 0; m < 4; ++m) dst##8[m] = PG8_LD8(lds + PG8_SA(b, h) + aoff + m * 2048); } \
        else { _Pragma("unroll") for (int m = 0; m < 4; ++m) _Pragma("unroll") for (int k = 0; k < 2; ++k) dst[m][k] = *(const LAS bf16x8*)(lds + PG8_SA(b, h) + aoff + m * 2048 + k * 1024); } } while (0)
#define PG8_LDB(dst, b, h) do { if constexpr (F8) { _Pragma("unroll") for (int n = 0; n < 2; ++n) dst##8[n] = PG8_LD8(lds + PG8_SB(b, h) + boff + n * 2048); } \
        else { _Pragma("unroll") for (int n = 0; n < 2; ++n) _Pragma("unroll") for (int k = 0; k < 2; ++k) dst[n][k] = *(const LAS bf16x8*)(lds + PG8_SB(b, h) + boff + n * 2048 + k * 1024); } } while (0)
#define PG8_MMA(ai, bj, At, Bt) do { __builtin_amdgcn_s_setprio(1); \
        if constexpr (F8) { _Pragma("unroll") for (int m = 0; m < 4; ++m) _Pragma("unroll") for (int n = 0; n < 2; ++n) \
            asm volatile("v_mfma_scale_f32_16x16x128_f8f6f4 %0, %1, %2, %0, %3, %4 op_sel_hi:[0,0,0]" : "+v"(acc[ai][bj][m][n]) : "v"(Bt##8[n]), "v"(At##8[m]), "v"((bj) ? g.sWu : g.sW), "v"(g.sA)); } \
        else if constexpr (I8) { _Pragma("unroll") for (int m = 0; m < 4; ++m) _Pragma("unroll") for (int n = 0; n < 2; ++n) _Pragma("unroll") for (int k = 0; k < 2; ++k) \
            acc[ai][bj][m][n] = __builtin_bit_cast(f32x4, __builtin_amdgcn_mfma_i32_16x16x64_i8(__builtin_bit_cast(v4i32, Bt[n][k]), __builtin_bit_cast(v4i32, At[m][k]), __builtin_bit_cast(v4i32, acc[ai][bj][m][n]), 0, 0, 0)); } \
        else { _Pragma("unroll") for (int m = 0; m < 4; ++m) _Pragma("unroll") for (int n = 0; n < 2; ++n) _Pragma("unroll") for (int k = 0; k < 2; ++k) \
            acc[ai][bj][m][n] = __builtin_amdgcn_mfma_f32_16x16x32_bf16(Bt[n][k], At[m][k], acc[ai][bj][m][n], 0, 0, 0); } \
        __builtin_amdgcn_s_setprio(0); } while (0)
#define PG8_WAIT_V(n) asm volatile("s_waitcnt vmcnt(" #n ")" ::: "memory")
#define PG8_WAIT_L(n) asm volatile("s_waitcnt lgkmcnt(" #n ")" ::: "memory")
#define PG8_BAR __builtin_amdgcn_s_barrier()
#define PG8_SCHED __builtin_amdgcn_sched_barrier(0)
    Unit cur, nxt; int ui = 0;
    if (!S.next(0, cur)) return;
    f32x4 acc[2][2][4][2];
#pragma unroll
    for (int a = 0; a < 2; ++a)
#pragma unroll
        for (int b = 0; b < 2; ++b)
#pragma unroll
            for (int m = 0; m < 4; ++m)
#pragma unroll
                for (int n = 0; n < 2; ++n) acc[a][b][m][n] = (f32x4){0.f, 0.f, 0.f, 0.f};
    bf16x8 At[4][2], B0[2][2], B1[2][2]; v8i32 At8[4], B08[2], B18[2];
    const int rstep = K * 2;
    int cA = cur.arow * rstep + (int)cur.koff; int cB = (int)cur.boff + cur.pn * tstep + (int)cur.koff;
    S.a_ready(cur);
    if constexpr (SP2) {
        PG8_STAGE(PG8_SB(0, 0), cB, voffB); PG8_STAGE(PG8_SB(0, 1), cB + hstep, voffB); PG8_STAGE(PG8_SA(0, 0), cA, voffA); PG8_STAGE(PG8_SA(0, 1), cA + hstep, voffA);
        if (wr == 1) PG8_BAR;
        PG8_WAIT_V(2); PG8_BAR;
        PG8_STAGE(PG8_SB(1, 0), cB + kstep, voffB); PG8_STAGE(PG8_SA(1, 0), cA + kstep, voffA); PG8_STAGE(PG8_SB(1, 1), cB + hstep + kstep, voffB);
        PG8_WAIT_V(6); PG8_BAR;
    } else {
        PG8_STAGE(PG8_SB(0, 0), cB, voffB); PG8_STAGE(PG8_SA(0, 0), cA, voffA); PG8_STAGE(PG8_SB(0, 1), cB + hstep, voffB); PG8_STAGE(PG8_SA(0, 1), cA + hstep, voffA);
        if (wr == 1) PG8_BAR;
        PG8_WAIT_V(4); PG8_BAR;
        PG8_STAGE(PG8_SB(1, 0), cB + kstep, voffB); PG8_STAGE(PG8_SA(1, 0), cA + kstep, voffA); PG8_STAGE(PG8_SB(1, 1), cB + hstep + kstep, voffB);
        PG8_WAIT_V(6); PG8_BAR;
    }
    for (;;) {
        const bool has_next = S.next(ui + 1, nxt);
        const int nA = has_next ? nxt.arow * rstep + (int)nxt.koff : cA; const int nB = has_next ? (int)nxt.boff + nxt.pn * tstep + (int)nxt.koff : cB;
        const int nt = cur.nt;
        for (int t = 0; t < nt; t += 2) {
            const bool last = (t == nt - 2);
            const int a1 = cA + (t + 1) * kstep;
            const int a2 = last ? nA : cA + (t + 2) * kstep; const int b2 = last ? nB : cB + (t + 2) * kstep;
            const int a3 = a2 + kstep; const int b3 = b2 + kstep;
            if (last && has_next) S.a_ready(nxt);
            if constexpr (SP2) {
            PG8_LDB(B0, 0, 0); PG8_LDB(B1, 0, 1); PG8_SCHED; PG8_LDA(At, 0, 0); PG8_STAGE(PG8_SA(1, 1), a1 + hstep, voffA);
            PG8_WAIT_V(8); PG8_WAIT_L(0); PG8_BAR; PG8_MMA(0, 0, At, B0); PG8_MMA(0, 1, At, B1); PG8_BAR; PG8_SCHED;
            PG8_LDA(At, 0, 1); PG8_STAGE(PG8_SB(0, 0), b2, voffB); PG8_STAGE(PG8_SB(0, 1), b2 + hstep, voffB); PG8_STAGE(PG8_SA(0, 0), a2, voffA);
            PG8_WAIT_V(8); PG8_WAIT_L(0); PG8_BAR; PG8_MMA(1, 0, At, B0); PG8_MMA(1, 1, At, B1); PG8_BAR; PG8_SCHED;
            PG8_LDB(B0, 1, 0); PG8_LDB(B1, 1, 1); PG8_SCHED; PG8_LDA(At, 1, 0); PG8_STAGE(PG8_SA(0, 1), a2 + hstep, voffA);
            PG8_WAIT_V(8); PG8_WAIT_L(0); PG8_BAR; PG8_MMA(0, 0, At, B0); PG8_MMA(0, 1, At, B1); PG8_BAR; PG8_SCHED;
            PG8_LDA(At, 1, 1); PG8_STAGE(PG8_SB(1, 0), b3, voffB); PG8_STAGE(PG8_SB(1, 1), b3 + hstep, voffB); PG8_STAGE(PG8_SA(1, 0), a3, voffA);
            PG8_WAIT_V(8); PG8_WAIT_L(0); PG8_BAR; PG8_MMA(1, 0, At, B0); PG8_MMA(1, 1, At, B1); PG8_BAR; PG8_SCHED;
            } else {
            PG8_LDB(B0, 0, 0); PG8_SCHED; PG8_LDA(At, 0, 0); PG8_STAGE(PG8_SA(1, 1), a1 + hstep, voffA);
            PG8_WAIT_L(8); PG8_BAR; PG8_WAIT_L(0); PG8_MMA(0, 0, At, B0); PG8_BAR; PG8_SCHED;
            PG8_LDB(B1, 0, 1); PG8_STAGE(PG8_SB(0, 0), b2, voffB);
            PG8_BAR; PG8_WAIT_L(0); PG8_MMA(0, 1, At, B1); PG8_BAR;
            PG8_LDA(At, 0, 1); PG8_STAGE(PG8_SA(0, 0), a2, voffA);
            PG8_BAR; PG8_WAIT_L(0); PG8_MMA(1, 0, At, B0); PG8_BAR; PG8_SCHED;
            PG8_STAGE(PG8_SB(0, 1), b2 + hstep, voffB);
            PG8_WAIT_V(6); PG8_BAR; PG8_MMA(1, 1, At, B1); PG8_BAR;
            PG8_LDB(B0, 1, 0); PG8_SCHED; PG8_LDA(At, 1, 0); PG8_STAGE(PG8_SA(0, 1), a2 + hstep, voffA);
            PG8_WAIT_L(8); PG8_BAR; PG8_WAIT_L(0); PG8_MMA(0, 0, At, B0); PG8_BAR; PG8_SCHED;
            PG8_LDB(B1, 1, 1); PG8_STAGE(PG8_SB(1, 0), b3, voffB);
            PG8_BAR; PG8_WAIT_L(0); PG8_MMA(0, 1, At, B1); PG8_BAR;
            PG8_LDA(At, 1, 1); PG8_STAGE(PG8_SA(1, 0), a3, voffA);
            PG8_BAR; PG8_WAIT_L(0); PG8_MMA(1, 0, At, B0); PG8_BAR; PG8_SCHED;
            PG8_STAGE(PG8_SB(1, 1), b3 + hstep, voffB);
            PG8_WAIT_V(6); PG8_BAR; PG8_MMA(1, 1, At, B1); PG8_BAR;
            }
        }
        if constexpr (F8) asm volatile("s_nop 15\n\ts_nop 15" ::: "memory");
        if constexpr (ALIGN_EPI) { if (wr == 0) PG8_BAR; }
        if constexpr (!Epi::AFTER_DRAIN) { E(acc, cur, wr, wc, fr, fq);
#if EPI_DUP
            asm volatile("" ::: "memory"); E(acc, cur, wr, wc, fr, fq);
#endif
            S.done(cur); }
        if (!has_next) break;
#pragma unroll
        for (int a = 0; a < 2; ++a)
#pragma unroll
            for (int b = 0; b < 2; ++b)
#pragma unroll
                for (int m = 0; m < 4; ++m)
#pragma unroll
                    for (int n = 0; n < 2; ++n) acc[a][b][m][n] = (f32x4){0.f, 0.f, 0.f, 0.f};
        cur = nxt; cA = nA; cB = nB; ++ui;
        if constexpr (ALIGN_EPI) { if (wr == 1) PG8_BAR; }
    }
    PG8_WAIT_V(0);
    if constexpr (!ALIGN_EPI) { if (wr == 0) PG8_BAR; }
    PG8_BAR;
#undef PG8_SA
#undef PG8_SB
#undef PG8_STAGE
#undef PG8_RS_voffA
#undef PG8_RS_voffB
#undef PG8_LDA
#undef PG8_LDB
#undef PG8_MMA
#undef PG8_LD8
#undef PG8_WAIT_V
#undef PG8_WAIT_L
#undef PG8_BAR
#undef PG8_SCHED
}
}

#define XB_TMO      128
#define XB_XCNT(j)  (256  + 64 * (j))
#define XB_XSUB(j)  (1280 + 64 * (j))
#define XB_XGEN(j)  (2304 + 64 * (j))
#define XB_TOP      3328
#define XB_TOPGEN   3392
#define XCD_BAR_WORDS 3456
#define XB_SPIN_CAP (1u << 18)

__device__ __forceinline__ unsigned xb_ld(unsigned* p)              { return __hip_atomic_load(p, __ATOMIC_RELAXED, __HIP_MEMORY_SCOPE_AGENT); }
__device__ __forceinline__ unsigned xb_add(unsigned* p, unsigned v) { return __hip_atomic_fetch_add(p, v, __ATOMIC_RELAXED, __HIP_MEMORY_SCOPE_AGENT); }
__device__ __forceinline__ unsigned xb_xcc_id() { return (unsigned)__builtin_amdgcn_s_getreg((3 << 11) | 20) & 0xFu; }
#define XB_SPIN(cond, bar) do { unsigned _sp = 0; while (cond) { __builtin_amdgcn_s_sleep(1); \
    if ((++_sp & 255u) == 0u) { if (xb_ld(&(bar)[XB_TMO])) break; if (_sp > XB_SPIN_CAP) { atomicAdd(&(bar)[XB_TMO], 1u); break; } } } } while (0)

struct XcdBarrier {
    unsigned* bar; unsigned x;
    volatile LAS unsigned* st;
};
__device__ __forceinline__ XcdBarrier xcd_barrier_post(unsigned* bar, volatile LAS unsigned* st) {
    XcdBarrier b; b.bar = bar; b.x = xb_xcc_id(); b.st = st;
    if (threadIdx.x == 0) (void)xb_add(&bar[XB_XCNT(b.x)], 1u);
    return b;
}
__device__ __forceinline__ void xcd_barrier_complete(unsigned* bar, unsigned x, unsigned& nloc, unsigned& nx) {
    const unsigned G = gridDim.x * gridDim.y * gridDim.z;
    unsigned sum, cnt, mine, sp = 0u;
    for (;;) {
        sum = 0u; cnt = 0u; mine = 0u;
#pragma unroll
        for (unsigned j = 0; j < 16; ++j) { const unsigned c = xb_ld(&bar[XB_XCNT(j)]); sum += c; cnt += (c > 0u) ? 1u : 0u; mine = (j == x) ? c : mine; }
        if (sum == G) break;
        __builtin_amdgcn_s_sleep(1);
        if ((++sp & 255u) == 0u) { if (xb_ld(&bar[XB_TMO])) break; if (sp > XB_SPIN_CAP) { atomicAdd(&bar[XB_TMO], 1u); break; } }
    }
    nloc = mine > 0u ? mine : 1u; nx = cnt > 0u ? cnt : 1u;
}
__device__ __forceinline__ void xcd_barrier(const XcdBarrier& b) {
    asm volatile("s_waitcnt vmcnt(0)" ::: "memory");
    __syncthreads();
    if (threadIdx.x == 0) {
        unsigned* bar = b.bar;
        __builtin_amdgcn_s_waitcnt(0);
        unsigned nloc = b.st[0], nx = b.st[1];
        if (nloc == 0u) { xcd_barrier_complete(bar, b.x, nloc, nx); b.st[0] = nloc; b.st[1] = nx; }
        const unsigned old = xb_add(&bar[XB_XSUB(b.x)], 1u);
        const unsigned gen = old / nloc;
        if (old + 1u == (gen + 1u) * nloc) {
            __builtin_amdgcn_fence(__ATOMIC_RELEASE, "agent");
            asm volatile("s_waitcnt vmcnt(0)" ::: "memory");
            const unsigned og = xb_add(&bar[XB_TOP], 1u);
            const unsigned tg = og / nx;
            if (og + 1u == (tg + 1u) * nx) xb_add(&bar[XB_TOPGEN], 1u);
            else XB_SPIN(xb_ld(&bar[XB_TOPGEN]) == tg, bar);
            __builtin_amdgcn_fence(__ATOMIC_ACQUIRE, "agent");
            xb_add(&bar[XB_XGEN(b.x)], 1u);
            asm volatile("s_waitcnt vmcnt(0)" ::: "memory");
        } else {
            XB_SPIN(xb_ld(&bar[XB_XGEN(b.x)]) == gen, bar);
            __builtin_amdgcn_fence(__ATOMIC_ACQUIRE, "agent");
            asm volatile("s_waitcnt vmcnt(0)" ::: "memory");
        }
    }
    __syncthreads();
}

struct Frame {
    LAS unsigned char* lds;
    unsigned* ctl;
    int tid, lane, wave;
    int vcu, G;
};

__device__ __forceinline__ int dest_row(int c, int F) { if (F == 0) return c; const int bj = (c >= F) ? 1 : 0; const int cc = c - bj * F; return (cc >> 7) * 256 + bj * 128 + (cc & 127); }
__device__ __forceinline__ void cvt_item(const float* W, int K, int N, bf16_t* WT, int F, LAS float* scr, int item, int lane) {
    const int nblk = N >> 6, kb = item / nblk, nb = item - kb * nblk, k0 = 64 * kb, n0 = 64 * nb;
    const float* src = W + (size_t)(k0 + (lane >> 4)) * N + n0 + 4 * (lane & 15);
#pragma unroll 8
    for (int i = 0; i < 16; ++i) { const f32x4 v = *(const GAS f32x4*)(src + (size_t)(4 * i) * N);
        LAS float* d = scr + (4 * i + (lane >> 4)) * 65 + 4 * (lane & 15); d[0] = v.x; d[1] = v.y; d[2] = v.z; d[3] = v.w; }
    LDS_WAIT(); asm volatile("" ::: "memory");
    const int c = lane & 7;
#pragma unroll
    for (int j = 0; j < 8; ++j) { const int n = (lane >> 3) + 8 * j; const LAS float* s = scr + (8 * c) * 65 + n;
        u32x4 o; o.x = cvt_pk_bf16(s[0 * 65], s[1 * 65]); o.y = cvt_pk_bf16(s[2 * 65], s[3 * 65]); o.z = cvt_pk_bf16(s[4 * 65], s[5 * 65]); o.w = cvt_pk_bf16(s[6 * 65], s[7 * 65]);
        *(GAS u32x4*)(WT + (size_t)dest_row(n0 + n, F) * K + k0 + 8 * c) = o; }
    LDS_WAIT(); asm volatile("" ::: "memory");
}
__device__ __forceinline__ unsigned pk4_fp8(float a, float b, float c, float d, float sc) {
    int t = 0;
    t = __builtin_amdgcn_cvt_pk_fp8_f32(__builtin_amdgcn_fmed3f(a * sc, -448.f, 448.f), __builtin_amdgcn_fmed3f(b * sc, -448.f, 448.f), t, false);
    t = __builtin_amdgcn_cvt_pk_fp8_f32(__builtin_amdgcn_fmed3f(c * sc, -448.f, 448.f), __builtin_amdgcn_fmed3f(d * sc, -448.f, 448.f), t, true);
    return (unsigned)t;
}
__device__ __forceinline__ void cvt_item8(const float* W, int K, int N, unsigned char* WT, int F, float sc, LAS float* scr, int item, int lane) {
    const int nblk = N >> 6, kb = item / nblk, nb = item - kb * nblk, k0 = 64 * kb, n0 = 64 * nb;
    const float* src = W + (size_t)(k0 + (lane >> 4)) * N + n0 + 4 * (lane & 15);
#pragma unroll 8
    for (int i = 0; i < 16; ++i) { const f32x4 v = *(const GAS f32x4*)(src + (size_t)(4 * i) * N);
        LAS float* d = scr + (4 * i + (lane >> 4)) * 65 + 4 * (lane & 15); d[0] = v.x; d[1] = v.y; d[2] = v.z; d[3] = v.w; }
    LDS_WAIT(); asm volatile("" ::: "memory");
    const int c = lane & 3;
#pragma unroll
    for (int j = 0; j < 4; ++j) { const int n = (lane >> 2) + 16 * j; const LAS float* s = scr + (16 * c) * 65 + n;
        u32x4 o; o.x = pk4_fp8(s[0 * 65], s[1 * 65], s[2 * 65], s[3 * 65], sc); o.y = pk4_fp8(s[4 * 65], s[5 * 65], s[6 * 65], s[7 * 65], sc);
        o.z = pk4_fp8(s[8 * 65], s[9 * 65], s[10 * 65], s[11 * 65], sc); o.w = pk4_fp8(s[12 * 65], s[13 * 65], s[14 * 65], s[15 * 65], sc);
        *(GAS u32x4*)(WT + (size_t)dest_row(n0 + n, F) * K + k0 + 16 * c) = o; }
    LDS_WAIT(); asm volatile("" ::: "memory");
}
__device__ __forceinline__ void norm_rows(const Frame& F, const float* X, const float* gain, bf16_t* Hout) {
    const int gw = F.vcu * NWAVES + F.wave, NGW = F.G * NWAVES;
    f32x4 gv[8];
#pragma unroll
    for (int j = 0; j < 8; ++j) gv[j] = *((const GAS f32x4*)gain + F.lane + 64 * j);
    for (int row = gw; row < T; row += NGW) {
        const GAS f32x4* xr = (const GAS f32x4*)(X + (size_t)row * DM) + F.lane;
        f32x4 v[8]; float s = 0.f;
#pragma unroll
        for (int j = 0; j < 8; ++j) { v[j] = xr[64 * j]; s += (v[j].x * v[j].x + v[j].y * v[j].y) + (v[j].z * v[j].z + v[j].w * v[j].w); }
        const float rstd = 1.0f / sqrtf(wave_sum(s) * (1.0f / DM) + EPS);
        GAS u32x2* o8 = (GAS u32x2*)(Hout + (size_t)row * DM) + F.lane;
#pragma unroll
        for (int j = 0; j < 8; ++j) { u32x2 w; w.x = cvt_pk_bf16(v[j].x * rstd * gv[j].x, v[j].y * rstd * gv[j].y); w.y = cvt_pk_bf16(v[j].z * rstd * gv[j].z, v[j].w * rstd * gv[j].w); o8[64 * j] = w; }
    }
}
__device__ __forceinline__ void norm_rows8(const Frame& F, const float* X, const float* gain, unsigned char* Hout) {
    const int gw = F.vcu * NWAVES + F.wave, NGW = F.G * NWAVES;
    f32x4 gv[8];
#pragma unroll
    for (int j = 0; j < 8; ++j) gv[j] = *((const GAS f32x4*)gain + F.lane + 64 * j);
    for (int row = gw; row < T; row += NGW) {
        const GAS f32x4* xr = (const GAS f32x4*)(X + (size_t)row * DM) + F.lane;
        f32x4 v[8]; float s = 0.f;
#pragma unroll
        for (int j = 0; j < 8; ++j) { v[j] = xr[64 * j]; s += (v[j].x * v[j].x + v[j].y * v[j].y) + (v[j].z * v[j].z + v[j].w * v[j].w); }
        const float rstd = 1.0f / sqrtf(wave_sum(s) * (1.0f / DM) + EPS);
        GAS unsigned* o4 = (GAS unsigned*)(Hout + (size_t)row * DM) + F.lane;
#pragma unroll
        for (int j = 0; j < 8; ++j) { const f32x4 hn = v[j] * rstd * gv[j]; o4[64 * j] = pk4_fp8(hn.x, hn.y, hn.z, hn.w, H8_SCALE); }
    }
}
__device__ __forceinline__ void norm_rows_i8(const Frame& F, const float* X, const float* gain, unsigned char* Hout) {
    const int gw = F.vcu * NWAVES + F.wave, NGW = F.G * NWAVES;
    f32x4 gv[8];
#pragma unroll
    for (int j = 0; j < 8; ++j) gv[j] = *((const GAS f32x4*)gain + F.lane + 64 * j);
    for (int row = gw; row < T; row += NGW) {
        const GAS f32x4* xr = (const GAS f32x4*)(X + (size_t)row * DM) + F.lane;
        f32x4 v[8]; float s = 0.f;
#pragma unroll
        for (int j = 0; j < 8; ++j) { v[j] = xr[64 * j]; s += (v[j].x * v[j].x + v[j].y * v[j].y) + (v[j].z * v[j].z + v[j].w * v[j].w); }
        const float rstd = 1.0f / sqrtf(wave_sum(s) * (1.0f / DM) + EPS);
        GAS unsigned* o4 = (GAS unsigned*)(Hout + (size_t)row * DM) + F.lane;
#pragma unroll
        for (int j = 0; j < 8; ++j) { const f32x4 hn = v[j] * rstd * gv[j]; o4[64 * j] = pk4_i8(hn.x, hn.y, hn.z, hn.w, HI8_SCALE); }
    }
}
__device__ __forceinline__ void norm_rows_i8b(const Frame& F, const bf16_t* X, const float* gain, unsigned char* Hout) {
    const int gw = F.vcu * NWAVES + F.wave, NGW = F.G * NWAVES;
    f32x4 gv[8];
#pragma unroll
    for (int j = 0; j < 8; ++j) gv[j] = *((const GAS f32x4*)gain + F.lane + 64 * j);
    for (int row = gw; row < T; row += NGW) {
        const GAS u32x2* xr = (const GAS u32x2*)(X + (size_t)row * DM) + F.lane;
        f32x4 v[8]; float s = 0.f;
#pragma unroll
        for (int j = 0; j < 8; ++j) { const u32x2 a = xr[64 * j]; v[j] = (f32x4){bf_lo(a.x), bf_hi(a.x), bf_lo(a.y), bf_hi(a.y)}; s += (v[j].x * v[j].x + v[j].y * v[j].y) + (v[j].z * v[j].z + v[j].w * v[j].w); }
        const float rstd = 1.0f / sqrtf(wave_sum(s) * (1.0f / DM) + EPS);
        GAS unsigned* o4 = (GAS unsigned*)(Hout + (size_t)row * DM) + F.lane;
#pragma unroll
        for (int j = 0; j < 8; ++j) { const f32x4 hn = v[j] * rstd * gv[j]; o4[64 * j] = pk4_i8(hn.x, hn.y, hn.z, hn.w, HI8_SCALE); }
    }
}
__device__ __forceinline__ void norm_rows_f32(const Frame& F, const float* X, const float* gain, float* out) {
    const int gw = F.vcu * NWAVES + F.wave, NGW = F.G * NWAVES;
    for (int row = gw; row < T; row += NGW) {
        const GAS f32x4* xr = (const GAS f32x4*)(X + (size_t)row * DM) + F.lane;
        f32x4 v[8]; float s = 0.f;
#pragma unroll
        for (int j = 0; j < 8; ++j) { v[j] = xr[64 * j]; s += (v[j].x * v[j].x + v[j].y * v[j].y) + (v[j].z * v[j].z + v[j].w * v[j].w); }
        const float rstd = 1.0f / sqrtf(wave_sum(s) * (1.0f / DM) + EPS);
        GAS f32x4* o = (GAS f32x4*)(out + (size_t)row * DM) + F.lane;
#pragma unroll
        for (int j = 0; j < 8; ++j) { const f32x4 gvv = *((const GAS f32x4*)gain + F.lane + 64 * j); o[64 * j] = v[j] * rstd * gvv; }
    }
}

struct Ptrs {
    const float *x, *ln_mix, *ln_ffn, *ln_final, *ret_w_in, *ret_w_out, *ffn_w_in, *ffn_w_out, *att_w_in, *att_w_out, *rel_bias, *router, *moe_w_in, *moe_w_out;
    float* out;
    bf16_t *W_RIN, *W_ROUT, *W_FIN, *W_FOUT, *W_AIN, *W_AOUT;
    unsigned char *W_MIN, *W_MOUT, *H8, *ACT2, *AG, *AO8, *AGC;
    bf16_t *H, *PROJ, *ACT, *QKV, *OB, *AO, *Y;
    bf16_t *X1, *X2, *X3; float* SSP; bf16_t* YB;
    int* LIST; unsigned* TOK;
};

constexpr int I_RIN = (DM / 64) * (NRET / 64), I_ROUT = (RHV / 64) * (DM / 64), I_FIN = (DM / 64) * (2 * FF / 64), I_FOUT = (FF / 64) * (DM / 64);
constexpr int I_AIN = (DM / 64) * (NATT / 64), I_AOUT = (DM / 64) * (DM / 64), I_MIN1 = (DM / 64) * (2 * FE / 64), I_MOUT1 = (FE / 64) * (DM / 64);
constexpr int NI_DENSE = I_RIN + I_ROUT + I_FIN + I_FOUT + I_AIN + I_AOUT, NITEMS = NI_DENSE + NE * I_MIN1 + NE * I_MOUT1;
constexpr int NI_SPLIT = I_RIN + I_ROUT;
struct P0Item { const float* src; unsigned char* dst; int N, K, F, k0, n0, fp8; float sc; };
__device__ __forceinline__ P0Item p0_decode(const Ptrs& P, int it) {
    P0Item d; int r = it;
    if (r < I_RIN) { d.src = P.ret_w_in; d.dst = (unsigned char*)P.W_RIN; d.N = NRET; d.K = DM; d.F = 0; d.fp8 = I8_RIN ? 2 : 0; d.sc = I8_RIN ? WI8_SCALE : 1.f; }
    else if ((r -= I_RIN) < I_ROUT) { d.src = P.ret_w_out; d.dst = (unsigned char*)P.W_ROUT; d.N = DM; d.K = RHV; d.F = 0; d.fp8 = 0; d.sc = 1.f; }
    else if ((r -= I_ROUT) < I_FIN) { d.src = P.ffn_w_in; d.dst = (unsigned char*)P.W_FIN; d.N = 2 * FF; d.K = DM; d.F = FF; d.fp8 = 2; d.sc = WI8_SCALE; }
    else if ((r -= I_FIN) < I_FOUT) { d.src = P.ffn_w_out; d.dst = (unsigned char*)P.W_FOUT; d.N = DM; d.K = FF; d.F = 0; d.fp8 = F8_FOUT ? 1 : 0; d.sc = F8_FOUT ? W2_SCALE : 1.f; }
    else if ((r -= I_FOUT) < I_AIN) { d.src = P.att_w_in; d.dst = (unsigned char*)P.W_AIN; d.N = NATT; d.K = DM; d.F = 0; d.fp8 = I8_QKV ? 2 : 1; d.sc = I8_QKV ? WI8_SCALE : W1_SCALE; }
    else if ((r -= I_AIN) < I_AOUT) { d.src = P.att_w_out; d.dst = (unsigned char*)P.W_AOUT; d.N = DM; d.K = DM; d.F = 0; d.fp8 = 1; d.sc = W1_SCALE; }
    else if ((r -= I_AOUT) < NE * I_MIN1) { const int e = r / I_MIN1; r -= e * I_MIN1; d.src = P.moe_w_in + (size_t)e * DM * 2 * FE; d.dst = P.W_MIN + (size_t)e * 2 * FE * DM; d.N = 2 * FE; d.K = DM; d.F = FE; d.fp8 = I8_MOE ? 2 : 1; d.sc = I8_MOE ? WI8_SCALE : W1_SCALE; }
    else { r -= NE * I_MIN1; const int e = r / I_MOUT1; r -= e * I_MOUT1; d.src = P.moe_w_out + (size_t)e * FE * DM; d.dst = P.W_MOUT + (size_t)e * DM * FE; d.N = DM; d.K = FE; d.F = 0; d.fp8 = 1; d.sc = W2_SCALE; }
    const int nblk = d.N >> 6, kb = r / nblk, nb = r - kb * nblk; d.k0 = 64 * kb; d.n0 = 64 * nb;
    return d;
}
#define P0_LOAD(D, R) do { const float* s_ = (D).src + (size_t)((D).k0 + (lane >> 4)) * (D).N + (D).n0 + 4 * (lane & 15); \
        _Pragma("unroll") for (int i = 0; i < 16; ++i) R[i] = *(const GAS f32x4*)(s_ + (size_t)(4 * i) * (D).N); } while (0)
__device__ __forceinline__ void p0_process(const P0Item& d, const f32x4 (&v)[16], LAS float* scr, int lane) {
#pragma unroll
    for (int i = 0; i < 16; ++i) { LAS float* q = scr + (4 * i + (lane >> 4)) * 65 + 4 * (lane & 15); q[0] = v[i].x; q[1] = v[i].y; q[2] = v[i].z; q[3] = v[i].w; }
    LDS_WAIT(); asm volatile("" ::: "memory");
    if (d.fp8) { const int c = lane & 3;
#pragma unroll
        for (int j = 0; j < 4; ++j) { const int n = (lane >> 2) + 16 * j; const LAS float* s = scr + (16 * c) * 65 + n;
            u32x4 o;
            if (d.fp8 == 2) { o.x = pk4_i8(s[0 * 65], s[1 * 65], s[2 * 65], s[3 * 65], d.sc); o.y = pk4_i8(s[4 * 65], s[5 * 65], s[6 * 65], s[7 * 65], d.sc);
                o.z = pk4_i8(s[8 * 65], s[9 * 65], s[10 * 65], s[11 * 65], d.sc); o.w = pk4_i8(s[12 * 65], s[13 * 65], s[14 * 65], s[15 * 65], d.sc); }
            else { o.x = pk4_fp8(s[0 * 65], s[1 * 65], s[2 * 65], s[3 * 65], d.sc); o.y = pk4_fp8(s[4 * 65], s[5 * 65], s[6 * 65], s[7 * 65], d.sc);
                o.z = pk4_fp8(s[8 * 65], s[9 * 65], s[10 * 65], s[11 * 65], d.sc); o.w = pk4_fp8(s[12 * 65], s[13 * 65], s[14 * 65], s[15 * 65], d.sc); }
            *(GAS u32x4*)(d.dst + (size_t)dest_row(d.n0 + n, d.F) * d.K + d.k0 + 16 * c) = o; }
    } else { const int c = lane & 7;
#pragma unroll
        for (int j = 0; j < 8; ++j) { const int n = (lane >> 3) + 8 * j; const LAS float* s = scr + (8 * c) * 65 + n;
            u32x4 o; o.x = cvt_pk_bf16(s[0 * 65], s[1 * 65]); o.y = cvt_pk_bf16(s[2 * 65], s[3 * 65]); o.z = cvt_pk_bf16(s[4 * 65], s[5 * 65]); o.w = cvt_pk_bf16(s[6 * 65], s[7 * 65]);
            *(GAS u32x4*)((bf16_t*)d.dst + (size_t)dest_row(d.n0 + n, d.F) * d.K + d.k0 + 8 * c) = o; }
    }
    LDS_WAIT(); asm volatile("" ::: "memory");
}
__device__ __forceinline__ void cvt_items(const Frame& F, const Ptrs& P, int lo, int hi, int w, int nw) {
    LAS float* scr = (LAS float*)(F.lds + F.wave * 16640);
    const int lane = F.lane;
    f32x4 ra[16], rb[16];
    int it = lo + w;
    if (it < hi) { P0Item da = p0_decode(P, it); P0_LOAD(da, ra);
        for (;;) {
            const int i1 = it + nw; P0Item db = da; if (i1 < hi) { db = p0_decode(P, i1); P0_LOAD(db, rb); }
            p0_process(da, ra, scr, lane);
            if (i1 >= hi) break;
            const int i2 = i1 + nw; if (i2 < hi) { da = p0_decode(P, i2); P0_LOAD(da, ra); }
            p0_process(db, rb, scr, lane);
            if (i2 >= hi) break;
            it = i2;
        }
    }
}

constexpr int CI_FIN = (DM / 128) * (2 * FF / 256), CI_FOUT = (FF / 128) * (DM / 256), CI_AIN = (DM / 128) * (NATT / 256), CI_AOUT = (DM / 128) * (DM / 256);
constexpr int CI_MIN1 = (DM / 128) * (2 * FE / 256), CI_MOUT1 = (FE / 128) * (DM / 256), NCI = CI_FIN + CI_FOUT + CI_AIN + CI_AOUT + NE * CI_MIN1 + NE * CI_MOUT1;
__device__ __forceinline__ P0Item c_decode(const Ptrs& P, int it) {
    P0Item d; int r = it;
    if (r < CI_FIN) { d.src = P.ffn_w_in; d.dst = (unsigned char*)P.W_FIN; d.N = 2 * FF; d.K = DM; d.F = FF; d.fp8 = 2; d.sc = WI8_SCALE; }
    else if ((r -= CI_FIN) < CI_FOUT) { d.src = P.ffn_w_out; d.dst = (unsigned char*)P.W_FOUT; d.N = DM; d.K = FF; d.F = 0; d.fp8 = 1; d.sc = W2_SCALE; }
    else if ((r -= CI_FOUT) < CI_AIN) { d.src = P.att_w_in; d.dst = (unsigned char*)P.W_AIN; d.N = NATT; d.K = DM; d.F = 0; d.fp8 = I8_QKV ? 2 : 1; d.sc = I8_QKV ? WI8_SCALE : W1_SCALE; }
    else if ((r -= CI_AIN) < CI_AOUT) { d.src = P.att_w_out; d.dst = (unsigned char*)P.W_AOUT; d.N = DM; d.K = DM; d.F = 0; d.fp8 = 1; d.sc = W1_SCALE; }
    else if ((r -= CI_AOUT) < NE * CI_MIN1) { const int e = r / CI_MIN1; r -= e * CI_MIN1; d.src = P.moe_w_in + (size_t)e * DM * 2 * FE; d.dst = P.W_MIN + (size_t)e * 2 * FE * DM; d.N = 2 * FE; d.K = DM; d.F = FE; d.fp8 = I8_MOE ? 2 : 1; d.sc = I8_MOE ? WI8_SCALE : W1_SCALE; }
    else { r -= NE * CI_MIN1; const int e = r / CI_MOUT1; r -= e * CI_MOUT1; d.src = P.moe_w_out + (size_t)e * FE * DM; d.dst = P.W_MOUT + (size_t)e * DM * FE; d.N = DM; d.K = FE; d.F = 0; d.fp8 = 1; d.sc = W2_SCALE; }
    const int nblk = d.N >> 8, kb = r / nblk, nb = r - kb * nblk; d.k0 = 128 * kb; d.n0 = 256 * nb;
    return d;
}
#define C_LOAD(D, R) do { const float* s_ = (D).src + (size_t)((D).k0 + 16 * wave) * (D).N + (D).n0 + 4 * lane; \
        _Pragma("unroll") for (int i = 0; i < 16; ++i) R[i] = *(const GAS f32x4*)(s_ + (size_t)i * (D).N); } while (0)
__device__ __forceinline__ void c_process(const P0Item& d, const f32x4 (&v)[16], LAS unsigned char* Tl, int wave, int lane) {
#pragma unroll
    for (int j = 0; j < 4; ++j) { u32x4 o;
        if (d.fp8 == 2) { o.x = pk4_i8(v[0][j], v[1][j], v[2][j], v[3][j], d.sc); o.y = pk4_i8(v[4][j], v[5][j], v[6][j], v[7][j], d.sc);
            o.z = pk4_i8(v[8][j], v[9][j], v[10][j], v[11][j], d.sc); o.w = pk4_i8(v[12][j], v[13][j], v[14][j], v[15][j], d.sc); }
        else { o.x = pk4_fp8(v[0][j], v[1][j], v[2][j], v[3][j], d.sc); o.y = pk4_fp8(v[4][j], v[5][j], v[6][j], v[7][j], d.sc);
            o.z = pk4_fp8(v[8][j], v[9][j], v[10][j], v[11][j], d.sc); o.w = pk4_fp8(v[12][j], v[13][j], v[14][j], v[15][j], d.sc); }
        *(LAS u32x4*)(Tl + (4 * lane + j) * 128 + ((wave ^ (lane & 7)) << 4)) = o; }
    __syncthreads();
#pragma unroll
    for (int q = 0; q < 4; ++q) { const int n = 32 * wave + 8 * q + (lane >> 3), c = lane & 7;
        const u32x4 o = *(const LAS u32x4*)(Tl + n * 128 + ((c ^ ((n >> 2) & 7)) << 4));
        *(GAS u32x4*)(d.dst + (size_t)dest_row(d.n0 + n, d.F) * d.K + d.k0 + 16 * c) = o; }
}
__device__ __forceinline__ void cvt_coop(const Frame& F, const Ptrs& P, int cw, int ncw) {
    const int lane = F.lane, wave = F.wave;
    f32x4 ra[16], rb[16];
    int it = cw, buf = 0;
    if (it >= NCI) return;
    P0Item da = c_decode(P, it); C_LOAD(da, ra);
    for (;;) {
        const int i1 = it + ncw; const bool h1 = i1 < NCI; P0Item db = da; if (h1) { db = c_decode(P, i1); C_LOAD(db, rb); }
        c_process(da, ra, F.lds + buf * 32768, wave, lane); buf ^= 1;
        if (!h1) break;
        const int i2 = i1 + ncw; const bool h2 = i2 < NCI; if (h2) { da = c_decode(P, i2); C_LOAD(da, ra); }
        c_process(db, rb, F.lds + buf * 32768, wave, lane); buf ^= 1;
        if (!h2) break;
        it = i2;
    }
}
__device__ __forceinline__ void p0_prologue(const Frame& F, const Ptrs& P) {
    cvt_items(F, P, 0, (F.G == 256) ? NI_SPLIT : NITEMS, F.vcu * NWAVES + F.wave, F.G * NWAVES);
    if (I8_RIN) norm_rows_i8(F, P.x, P.ln_mix, P.H8); else norm_rows(F, P.x, P.ln_mix, P.H);
}

__device__ __forceinline__ float row16_sum(float v) {
    v += __builtin_bit_cast(float, __builtin_amdgcn_update_dpp(0, __builtin_bit_cast(int, v), 0xB1, 0xf, 0xf, true));
    v += __builtin_bit_cast(float, __builtin_amdgcn_update_dpp(0, __builtin_bit_cast(int, v), 0x4E, 0xf, 0xf, true));
    v += __builtin_bit_cast(float, __builtin_amdgcn_update_dpp(0, __builtin_bit_cast(int, v), 0x141, 0xf, 0xf, true));
    v += __builtin_bit_cast(float, __builtin_amdgcn_update_dpp(0, __builtin_bit_cast(int, v), 0x140, 0xf, 0xf, true));
    return v;
}
__device__ __forceinline__ s16x4 lds_tr(LAS unsigned char* p) { return __builtin_amdgcn_ds_read_tr16_b64_v4i16((LAS s16x4*)p); }
__device__ __forceinline__ f32x4 mfma16(bf16x8 a, bf16x8 b, f32x4 c) { return __builtin_amdgcn_mfma_f32_16x16x32_bf16(a, b, c, 0, 0, 0); }
#define CAT8(lo, hi) ((bf16x8){(lo)[0], (lo)[1], (lo)[2], (lo)[3], (hi)[0], (hi)[1], (hi)[2], (hi)[3]})

__device__ __forceinline__ void retention_phase(const Frame& F, const Ptrs& P) {
    constexpr int QS = 0, KS = 33792, VS = 67584, SSO = 84992, SSW = 94208;
    constexpr int QST = 528, VST = 272, SST = 144;
    LAS unsigned char* L = F.lds;
    const int tid = F.tid, lane = F.lane, w = F.wave, c16 = lane & 15, g = lane >> 4, q4 = c16 >> 2, p4 = c16 & 3;
    const bool split = (F.G == 256);
    const int bx = (int)blockIdx.x, ridx = (bx >> 3) * 4 + ((bx & 7) >> 1);
    if (split && (bx & 1)) { cvt_coop(F, P, ridx, 128); return; }
    const int u0 = split ? ridx : bx, ustep = split ? 128 : F.G;
    for (int unit = u0; unit < NBATCH * RH * 4; unit += ustep) {
        const int b = unit >> 5, h = (unit >> 2) & 7, vs = unit & 3;
        const float xg = __builtin_amdgcn_exp2f(-(float)(5 + h));
        const float l2g = -(xg * (1.f + xg * (0.5f + xg * (1.f / 3.f + xg * (0.25f + xg * (0.2f + xg * (1.f / 6.f))))))) * LOG2E;
        const float cdec = __builtin_amdgcn_exp2f(l2g * 64.f);
        f32x4 st[16];
#pragma unroll
        for (int i = 0; i < 16; ++i) st[i] = (f32x4){0.f, 0.f, 0.f, 0.f};
        u32x4 rq[4], rk[4], rv[2];
        const unsigned lqk = (unsigned)((tid >> 5) * NRET + (tid & 31) * 8), lvv = (unsigned)((tid >> 4) * NRET + (tid & 15) * 8);
#define RET_LOAD(cc) do { const bf16_t* pb = P.PROJ + ((size_t)b * SEQ + (size_t)(cc) * CHUNK) * NRET; \
            _Pragma("unroll") for (int i = 0; i < 4; ++i) { const bf16_t* src = pb + (size_t)(16 * i) * NRET + h * RDK; \
                rq[i] = *(const GAS u32x4*)(src + lqk); rk[i] = *(const GAS u32x4*)(src + DM + lqk); } \
            _Pragma("unroll") for (int i = 0; i < 2; ++i) { const bf16_t* src = pb + (size_t)(32 * i) * NRET + 2 * DM + h * RDV + vs * 128; \
                rv[i] = *(const GAS u32x4*)(src + lvv); } } while (0)
        RET_LOAD(0);
        for (int c = 0; c < SEQ / CHUNK; ++c) {
            const size_t t0 = (size_t)b * SEQ + (size_t)c * CHUNK;
            __syncthreads();
            if (c > 0 && tid < 64) { float s = 0.f;
#pragma unroll
                for (int ww = 0; ww < 8; ++ww) s += *(LAS float*)(L + SSW + (ww * 64 + tid) * 4);
                P.SSP[(t0 - CHUNK + tid) * 32 + h * 4 + vs] = s; }
#pragma unroll
            for (int i = 0; i < 4; ++i) { const int ci = tid + 512 * i, row = ci >> 5, ch = ci & 31;
                *(LAS u32x4*)(L + QS + row * QST + ch * 16) = rq[i]; *(LAS u32x4*)(L + KS + row * QST + ch * 16) = rk[i]; }
#pragma unroll
            for (int i = 0; i < 2; ++i) { const int ci = tid + 512 * i, row = ci >> 4, ch = ci & 15; *(LAS u32x4*)(L + VS + row * VST + ch * 16) = rv[i]; }
            __syncthreads();
            if (c + 1 < SEQ / CHUNK) RET_LOAD(c + 1);
            float lg = l2g; int gq = 4 * g, cq = c16;
            asm volatile("" : "+v"(lg), "+v"(gq), "+v"(cq));
            {
                const int nt = w >> 1;
                f32x4 a4[2] = {(f32x4){0.f, 0.f, 0.f, 0.f}, (f32x4){0.f, 0.f, 0.f, 0.f}};
#pragma unroll
                for (int s = 0; s < 8; ++s) { const bf16x8 qb = *(const LAS bf16x8*)(L + QS + (16 * nt + c16) * QST + (32 * s + 8 * g) * 2);
#pragma unroll
                    for (int mi = 0; mi < 2; ++mi) { const int mt = 2 * (w & 1) + mi;
                        const bf16x8 ka = *(const LAS bf16x8*)(L + KS + (16 * mt + c16) * QST + (32 * s + 8 * g) * 2);
                        a4[mi] = mfma16(ka, qb, a4[mi]); } }
                const int n = 16 * nt + c16;
#pragma unroll
                for (int mi = 0; mi < 2; ++mi) { const int mt = 2 * (w & 1) + mi; const int nm = 16 * (nt - mt) + cq - gq;
#pragma unroll
                    for (int r = 0; r < 4; ++r) { const int d0 = nm - r; const int dd = d0 < 0 ? -d0 : d0; a4[mi][r] *= __builtin_amdgcn_exp2f(lg * (float)dd); }
                    u32x2 pk; pk.x = cvt_pk_bf16(a4[mi][0], a4[mi][1]); pk.y = cvt_pk_bf16(a4[mi][2], a4[mi][3]);
                    *(LAS u32x2*)(L + SSO + n * SST + (16 * mt + 4 * g) * 2) = pk; }
            }
            __syncthreads();
            f32x4 ac[4];
#pragma unroll
            for (int nt = 0; nt < 4; ++nt) ac[nt] = (f32x4){0.f, 0.f, 0.f, 0.f};
#pragma unroll
            for (int s = 0; s < 8; ++s) { u32x4 pw; pw.x = cvt_pk_bf16(st[2 * s][0], st[2 * s][1]); pw.y = cvt_pk_bf16(st[2 * s][2], st[2 * s][3]);
                pw.z = cvt_pk_bf16(st[2 * s + 1][0], st[2 * s + 1][1]); pw.w = cvt_pk_bf16(st[2 * s + 1][2], st[2 * s + 1][3]); const bf16x8 sbs = __builtin_bit_cast(bf16x8, pw);
#pragma unroll
                for (int nt = 0; nt < 4; ++nt) { const s16x4 lo = *(const LAS s16x4*)(L + QS + (16 * nt + c16) * QST + (32 * s + 4 * g) * 2);
                    const s16x4 hi = *(const LAS s16x4*)(L + QS + (16 * nt + c16) * QST + (32 * s + 16 + 4 * g) * 2);
                    ac[nt] = mfma16(CAT8(lo, hi), sbs, ac[nt]); }
                if (s & 1) __builtin_amdgcn_sched_barrier(0); }
#pragma unroll
            for (int nt = 0; nt < 4; ++nt)
#pragma unroll
                for (int r = 0; r < 4; ++r) ac[nt][r] *= __builtin_amdgcn_exp2f(fmaf(lg, (float)(16 * nt + r + 1), lg * (float)gq));
            bf16x8 vf[2];
#pragma unroll
            for (int s = 0; s < 2; ++s) { const s16x4 lo = lds_tr(L + VS + (32 * s + 8 * g + q4) * VST + (16 * w + 4 * p4) * 2);
                const s16x4 hi = lds_tr(L + VS + (32 * s + 8 * g + 4 + q4) * VST + (16 * w + 4 * p4) * 2);
                vf[s] = CAT8(lo, hi); }
#pragma unroll
            for (int s = 0; s < 2; ++s)
#pragma unroll
                for (int nt = 0; nt < 4; ++nt) { const bf16x8 sa = *(const LAS bf16x8*)(L + SSO + (16 * nt + c16) * SST + (32 * s + 8 * g) * 2); ac[nt] = mfma16(sa, vf[s], ac[nt]); }
            f32x4 sqv[4];
            const unsigned obo = (unsigned)(4 * g * RHV + c16);
#pragma unroll
            for (int nt = 0; nt < 4; ++nt) {
#pragma unroll
                for (int r = 0; r < 4; ++r) { const float o = ac[nt][r];
                    ((GAS bf16_t*)(P.OB + (t0 + 16 * nt + r) * RHV + h * RDV + vs * 128 + 16 * w))[obo] = (bf16_t)(cvt_pk_bf16(o, 0.f) & 0xffffu);
                    sqv[nt][r] = row16_sum(o * o); } }
            if (c16 == 0) {
#pragma unroll
                for (int nt = 0; nt < 4; ++nt) *(LAS f32x4*)(L + SSW + (w * 64 + 16 * nt + 4 * g) * 4) = sqv[nt]; }
            __builtin_amdgcn_sched_barrier(0);
            bf16x8 vd[2];
#pragma unroll
            for (int s = 0; s < 2; ++s) { float fv[8];
#pragma unroll
                for (int j = 0; j < 8; ++j) fv[j] = __uint_as_float(((unsigned)(unsigned short)vf[s][j]) << 16) * __builtin_amdgcn_exp2f(fmaf(lg, (float)(63 - 32 * s - j), -2.0f * lg * (float)gq));
                u32x4 pw; pw.x = cvt_pk_bf16(fv[0], fv[1]); pw.y = cvt_pk_bf16(fv[2], fv[3]); pw.z = cvt_pk_bf16(fv[4], fv[5]); pw.w = cvt_pk_bf16(fv[6], fv[7]);
                vd[s] = __builtin_bit_cast(bf16x8, pw); }
#pragma unroll
            for (int dt = 0; dt < 16; ++dt) { st[dt] = st[dt] * cdec;
#pragma unroll
                for (int s = 0; s < 2; ++s) { const s16x4 lo = lds_tr(L + KS + (32 * s + 8 * g + q4) * QST + (16 * dt + 4 * p4) * 2);
                    const s16x4 hi = lds_tr(L + KS + (32 * s + 8 * g + 4 + q4) * QST + (16 * dt + 4 * p4) * 2);
                    st[dt] = mfma16(CAT8(lo, hi), vd[s], st[dt]); }
                if (dt & 1) __builtin_amdgcn_sched_barrier(0); }
        }
#undef RET_LOAD
        __syncthreads();
        if (tid < 64) { float s = 0.f;
#pragma unroll
            for (int ww = 0; ww < 8; ++ww) s += *(LAS float*)(L + SSW + (ww * 64 + tid) * 4);
            P.SSP[((size_t)b * SEQ + SEQ - CHUNK + tid) * 32 + h * 4 + vs] = s; }
    }
}
__device__ __forceinline__ void gate_phase(const Frame& F, const Ptrs& P) {
    const int gw = F.vcu * NWAVES + F.wave, NGW = F.G * NWAVES;
    for (int row = gw; row < T; row += NGW) {
#pragma unroll
        for (int j = 0; j < 8; ++j) {
            const int idx = F.lane + 64 * j;
            const u32x4 ov = *((const GAS u32x4*)(P.OB + (size_t)row * RHV) + idx);
            const u32x4 gv = *((const GAS u32x4*)(P.PROJ + (size_t)row * NRET + 2 * DM + RHV) + idx);
            const f32x4 ss = *(const GAS f32x4*)(P.SSP + (size_t)row * 32 + 4 * j);
            const float rstd = 1.0f / sqrtf(((ss.x + ss.y) + (ss.z + ss.w)) * (1.0f / RDV) + EPS);
            u32x4 yo;
#define GATE1(W) cvt_pk_bf16(silu_f(bf_lo(gv.W)) * bf_lo(ov.W) * rstd, silu_f(bf_hi(gv.W)) * bf_hi(ov.W) * rstd)
            yo.x = GATE1(x); yo.y = GATE1(y); yo.z = GATE1(z); yo.w = GATE1(w);
#undef GATE1
            *((GAS u32x4*)(P.Y + (size_t)row * RHV) + idx) = yo;
        }
    }
}

__device__ __forceinline__ int crow(int r, int hi) { return (r & 3) + 8 * (r >> 2) + 4 * hi; }
#define KSWZ(row, colB) ((row) * 256 + ((colB) ^ (((row) & 7) << 4)))
__device__ __forceinline__ int v_st(int k, int c) { const int kk = (k & ~0xC) | ((k & 4) << 1) | ((k & 8) >> 1); return ((kk >> 3) * 4 + (c >> 5)) * 512 + ((kk & 7) * 32 + (c & 31)) * 2; }
__device__ __forceinline__ int v_rd_base(int lane) { return ((lane & 3) << 3) | (((lane >> 2) & 3) << 6) | (((lane >> 4) & 1) << 5) | (((lane >> 5) & 1) << 8); }
__device__ __forceinline__ f32x16 mfma32(bf16x8 a, bf16x8 b, f32x16 c) { return __builtin_amdgcn_mfma_f32_32x32x16_bf16(a, b, c, 0, 0, 0); }

__device__ __forceinline__ void attention_phase(const Frame& F, const Ptrs& P) {
    constexpr int VL = 0, KL = 32768, WSL = 65536, BL = 67584;
    constexpr float C = 0.08838834764831845f * LOG2E;
    LAS unsigned char* L = F.lds;
    const int tid = F.tid, lane = F.lane, w = F.wave, r32 = lane & 31, hi = lane >> 5;
    LAS float* al_l = (LAS float*)(L + WSL + w * 256); LAS float* li_l = al_l + 32;
    const int sr = tid >> 4, sc = (tid & 15) * 8, vst0 = v_st(sr, sc), vst1 = v_st(32 + sr, sc);
    const int vb = VL + v_rd_base(lane);
    for (int uj = blockIdx.x; uj < NBATCH * AH * 8 * ((DUP_MASK & 0x400) ? 2 : 1); uj += F.G) {
        const int ui = uj & (NBATCH * AH * 8 - 1);
        const int qb = ui >> 7, bh = ui & 127, b = bh >> 4, h = bh & 15;
        __syncthreads();
        if (tid < 257) *(LAS float*)(L + BL + tid * 4) = P.rel_bias[h * 257 + tid] * LOG2E;
        const size_t tq0 = (size_t)b * SEQ + (size_t)qb * 256;
        bf16x8 qr[8];
        { const bf16_t* Qw = P.QKV + (tq0 + 32 * w + r32) * NATT + h * AD + hi * 8;
#pragma unroll
          for (int d0 = 0; d0 < 8; ++d0) qr[d0] = *(const GAS bf16x8*)(Qw + d0 * 16); }
        const int kt_lo = (4 * qb - 8) > 0 ? (4 * qb - 8) : 0, kt_hi = 4 * qb + 3, cw = 4 * qb + (w >> 1), qrow = (w & 1) * 32 + r32;
        float m_reg = -1e30f, l_reg = 0.f; f32x16 o[4];
#pragma unroll
        for (int d = 0; d < 4; ++d)
#pragma unroll
            for (int r = 0; r < 16; ++r) o[d][r] = 0.f;
        u32x4 sk0, sk1, sv0, sv1;
#define ASLOAD(kt) do { const bf16_t* kp = P.QKV + ((size_t)b * SEQ + (size_t)(kt) * 64 + sr) * NATT + DM + h * AD + sc; \
        sk0 = *(const GAS u32x4*)(kp); sk1 = *(const GAS u32x4*)(kp + (size_t)32 * NATT); sv0 = *(const GAS u32x4*)(kp + DM); sv1 = *(const GAS u32x4*)(kp + (size_t)32 * NATT + DM); } while (0)
        ASLOAD(kt_lo);
        for (int kt = kt_lo; kt <= kt_hi; ++kt) {
            const int bo = (kt & 1) * 16384;
            *(LAS u32x4*)(L + VL + bo + vst0) = sv0; *(LAS u32x4*)(L + VL + bo + vst1) = sv1;
            *(LAS u32x4*)(L + KL + bo + KSWZ(sr, sc * 2)) = sk0; *(LAS u32x4*)(L + KL + bo + KSWZ(32 + sr, sc * 2)) = sk1;
            __syncthreads();
            if (kt < kt_hi) ASLOAD(kt + 1);
            const int delta = cw - kt;
            if (delta >= 0 && delta <= 8) {
                f32x16 p0, p1;
#pragma unroll
                for (int r = 0; r < 16; ++r) { p0[r] = 0.f; p1[r] = 0.f; }
#pragma unroll
                for (int d0 = 0; d0 < 8; ++d0) { const int cb = (d0 * 16 + hi * 8) * 2;
                    const bf16x8 k0 = *(const LAS bf16x8*)(L + KL + bo + KSWZ(r32, cb));
                    const bf16x8 k1 = *(const LAS bf16x8*)(L + KL + bo + KSWZ(32 + r32, cb));
                    p0 = mfma32(k0, qr[d0], p0); p1 = mfma32(k1, qr[d0], p1);
                    if ((d0 & 3) == 3) __builtin_amdgcn_sched_barrier(0); }
                if (delta >= 3) { const float bc = *(LAS float*)(L + BL + 256 * 4);
#pragma unroll
                    for (int r = 0; r < 16; ++r) { p0[r] = fmaf(p0[r], C, bc); p1[r] = fmaf(p1[r], C, bc); }
                } else { const int base = qrow + 64 * delta + 128 - 4 * hi;
#pragma unroll
                    for (int r = 0; r < 16; ++r) { int i0 = base - ((r & 3) + 8 * (r >> 2)); int i1 = i0 - 32; i0 = i0 > 256 ? 256 : i0; i1 = i1 > 256 ? 256 : i1;
                        p0[r] = fmaf(p0[r], C, *(LAS float*)(L + BL + i0 * 4)); p1[r] = fmaf(p1[r], C, *(LAS float*)(L + BL + i1 * 4)); }
                }
                float pmax = p0[0];
#pragma unroll
                for (int r = 1; r < 16; ++r) pmax = fmaxf(pmax, p0[r]);
#pragma unroll
                for (int r = 0; r < 16; ++r) pmax = fmaxf(pmax, p1[r]);
                { auto rr = __builtin_amdgcn_permlane32_swap(__float_as_uint(pmax), __float_as_uint(pmax), false, false); pmax = fmaxf(__uint_as_float(rr[0]), __uint_as_float(rr[1])); }
                const float mn = fmaxf(m_reg, pmax), alpha = __builtin_amdgcn_exp2f(m_reg - mn); m_reg = mn;
                float ps = 0.f;
#pragma unroll
                for (int r = 0; r < 16; ++r) { p0[r] = __builtin_amdgcn_exp2f(p0[r] - mn); p1[r] = __builtin_amdgcn_exp2f(p1[r] - mn); ps += p0[r] + p1[r]; }
                { auto rr = __builtin_amdgcn_permlane32_swap(__float_as_uint(ps), __float_as_uint(ps), false, false); ps = __uint_as_float(rr[0]) + __uint_as_float(rr[1]); }
                l_reg = l_reg * alpha + ps;
                if (__any(alpha != 1.0f)) {
                if (hi == 0) al_l[r32] = alpha;
                LDS_WAIT();
#pragma unroll
                for (int r = 0; r < 16; ++r) { const float a = al_l[crow(r, hi)];
#pragma unroll
                    for (int d = 0; d < 4; ++d) o[d][r] *= a; } }
                bf16x8 pa[4];
#define PK4(PP, BASE, OUT) do { unsigned a0 = cvt_pk_bf16(PP[BASE + 0], PP[BASE + 1]), a1 = cvt_pk_bf16(PP[BASE + 2], PP[BASE + 3]);   \
                    unsigned b0 = cvt_pk_bf16(PP[BASE + 4], PP[BASE + 5]), b1 = cvt_pk_bf16(PP[BASE + 6], PP[BASE + 7]);                          \
                    auto r0 = __builtin_amdgcn_permlane32_swap(a0, b0, false, false); auto r1 = __builtin_amdgcn_permlane32_swap(a1, b1, false, false); \
                    u32x4 ww = {r0[0], r1[0], r0[1], r1[1]}; OUT = __builtin_bit_cast(bf16x8, ww); } while (0)
                PK4(p0, 0, pa[0]); PK4(p0, 8, pa[1]); PK4(p1, 0, pa[2]); PK4(p1, 8, pa[3]);
#undef PK4
#pragma unroll
                for (int d0 = 0; d0 < 4; ++d0) {
#pragma unroll
                    for (int ks = 0; ks < 4; ++ks) { const s16x4 lo = lds_tr(L + bo + vb + d0 * 512 + ks * 4096); const s16x4 hh = lds_tr(L + bo + vb + d0 * 512 + ks * 4096 + 2048);
                        o[d0] = mfma32(pa[ks], CAT8(lo, hh), o[d0]); }
                    __builtin_amdgcn_sched_barrier(0); }
            }
        }
#undef ASLOAD
        if (hi == 0) li_l[r32] = l_reg;
        LDS_WAIT();
        unsigned char* Ow = P.AO8 + (tq0 + 32 * w) * DM + h * AD;
        const unsigned eo = (unsigned)(4 * hi * DM + r32);
#pragma unroll
        for (int r = 0; r < 16; ++r) { const int orow = crow(r, hi); const float rl = __builtin_amdgcn_rcpf(li_l[orow]);
            unsigned char* Or = Ow + (size_t)((r & 3) + 8 * (r >> 2)) * DM; const float rs = rl * H8_SCALE;
#pragma unroll
            for (int d0 = 0; d0 < 4; ++d0) Or[eo + d0 * 32] = (unsigned char)(__builtin_amdgcn_cvt_pk_fp8_f32(__builtin_amdgcn_fmed3f(o[d0][r] * rs, -448.f, 448.f), 0.f, 0, false) & 0xff);
            if ((r & 3) == 3) __builtin_amdgcn_sched_barrier(0); }
    }
}

__device__ __forceinline__ void router_phase(const Frame& F, const Ptrs& P) {
    LAS float* WR = (LAS float*)F.lds;
    LAS unsigned* RI = (LAS unsigned*)(F.lds + 65536);
    LAS unsigned* EC = (LAS unsigned*)(F.lds + 65536 + 2048);
    for (int i = F.tid; i < DM * NE / 4; i += NWAVES * 64) ((LAS f32x4*)WR)[i] = ((const GAS f32x4*)P.router)[i];
    const int gw = F.vcu * NWAVES + F.wave, NGW = F.G * NWAVES;
    const float* gain = P.ln_ffn + DM;
    f32x4 gvr[8];
#pragma unroll
    for (int j = 0; j < 8; ++j) gvr[j] = *((const GAS f32x4*)gain + F.lane + 64 * j);
    constexpr int RB = 4;
    for (int row0 = gw; row0 < T; row0 += RB * NGW) {
        if (F.tid < 16) EC[F.tid] = 0u;
        __syncthreads();
        unsigned rowpk[RB][8];
#pragma unroll
        for (int it = 0; it < RB; ++it) { const int row = row0 + it * NGW; const bool live = row < T; const int rr_ = live ? row : row0;
            const GAS u32x2* xr = (const GAS u32x2*)(P.X3 + (size_t)rr_ * DM) + F.lane;
            f32x4 v[8]; float s = 0.f;
#pragma unroll
            for (int j = 0; j < 8; ++j) { const u32x2 a = xr[64 * j]; v[j] = (f32x4){bf_lo(a.x), bf_hi(a.x), bf_lo(a.y), bf_hi(a.y)}; s += (v[j].x * v[j].x + v[j].y * v[j].y) + (v[j].z * v[j].z + v[j].w * v[j].w); }
            const float rstd = 1.0f / sqrtf(wave_sum(s) * (1.0f / DM) + EPS);
            float lg[8];
            int lz = F.lane; asm volatile("" : "+v"(lz));
#pragma unroll
            for (int e = 0; e < 8; ++e) lg[e] = 0.f;
#pragma unroll
            for (int j = 0; j < 8; ++j) { const f32x4 hn = v[j] * rstd * gvr[j];
                rowpk[it][j] = I8_MOE ? pk4_i8(hn.x, hn.y, hn.z, hn.w, HI8_SCALE) : pk4_fp8(hn.x, hn.y, hn.z, hn.w, H8_SCALE);
#pragma unroll
                for (int i = 0; i < 4; ++i) { const LAS f32x4* wp = (const LAS f32x4*)(WR + (4 * (lz + 64 * j) + i) * 8); const f32x4 w0 = wp[0], w1 = wp[1]; const float hv = hn[i];
                    lg[0] += hv * w0.x; lg[1] += hv * w0.y; lg[2] += hv * w0.z; lg[3] += hv * w0.w; lg[4] += hv * w1.x; lg[5] += hv * w1.y; lg[6] += hv * w1.z; lg[7] += hv * w1.w; } }
#pragma unroll
            for (int e = 0; e < 8; ++e) lg[e] = wave_sum(lg[e]);
            int i1 = 0; float v1 = lg[0];
#pragma unroll
            for (int e = 1; e < 8; ++e) if (lg[e] > v1) { v1 = lg[e]; i1 = e; }
            int i2 = -1; float v2 = -3.0e38f;
#pragma unroll
            for (int e = 0; e < 8; ++e) if (e != i1 && lg[e] > v2) { v2 = lg[e]; i2 = e; }
            if (F.lane == 0 && live) {
                const float g1 = 1.0f / (1.0f + __expf(v2 - v1)), g2 = 1.0f - g1;
                const unsigned r1 = __hip_atomic_fetch_add(EC + i1, 1u, __ATOMIC_RELAXED, __HIP_MEMORY_SCOPE_WORKGROUP);
                const unsigned r2 = __hip_atomic_fetch_add(EC + i2, 1u, __ATOMIC_RELAXED, __HIP_MEMORY_SCOPE_WORKGROUP);
                LAS unsigned* ri = RI + (F.wave * 8 + it) * 8;
                ri[0] = (unsigned)i1; ri[1] = r1; ri[2] = (unsigned)i2; ri[3] = r2; ri[4] = __float_as_uint(g1); ri[5] = __float_as_uint(g2);
            }
            asm volatile("" ::: "memory"); __builtin_amdgcn_sched_barrier(0);
        }
        __syncthreads();
        if (F.tid < 8) EC[8 + F.tid] = __hip_atomic_fetch_add(F.ctl + CW_CNT + 64 * F.tid, EC[F.tid], RLX_AGENT);
        __syncthreads();
#pragma unroll
        for (int it = 0; it < RB; ++it) { const int row = row0 + it * NGW;
            if (row < T) { const LAS unsigned* ri = RI + (F.wave * 8 + it) * 8;
                const unsigned i1 = ri[0], i2 = ri[2], p1 = EC[8 + i1] + ri[1], p2 = EC[8 + i2] + ri[3];
                GAS unsigned* d1 = (GAS unsigned*)(P.AGC + ((size_t)i1 * T + p1) * DM) + F.lane; GAS unsigned* d2 = (GAS unsigned*)(P.AGC + ((size_t)i2 * T + p2) * DM) + F.lane;
#pragma unroll
                for (int j = 0; j < 8; ++j) { d1[64 * j] = rowpk[it][j]; d2[64 * j] = rowpk[it][j]; }
                if (F.lane == 0) { u32x4 t4; t4.x = i1; t4.y = p1; t4.z = i2; t4.w = p2;
                    *(GAS u32x4*)(P.TOK + (size_t)row * 8) = t4;
                    u32x2 g2v; g2v.x = ri[4]; g2v.y = ri[5];
                    *(GAS u32x2*)(P.TOK + (size_t)row * 8 + 4) = g2v; } } }
        __syncthreads();
    }
}
__device__ __forceinline__ void moe_offsets(const Frame& F, int (&toff)[9], int (&cnt)[8]) {
    int acc = 0;
#pragma unroll
    for (int e = 0; e < 8; ++e) { cnt[e] = __builtin_amdgcn_readfirstlane((int)__hip_atomic_load(F.ctl + CW_CNT + 64 * e, RLX_AGENT)); toff[e] = acc; acc += (cnt[e] + 255) >> 8; }
    toff[8] = acc;
}
__device__ __forceinline__ void gather_phase(const Frame& F, const Ptrs& P) {
    int toff[9], cnt[8]; moe_offsets(F, toff, cnt);
    const int gw = F.vcu * NWAVES + F.wave, NGW = F.G * NWAVES, R = toff[8] * 256;
    for (int r = gw; r < R; r += NGW) {
        const int tile = r >> 8; int e = 0;
#pragma unroll
        for (int j = 1; j < 8; ++j) e += (tile >= toff[j]) ? 1 : 0;
        const int pos = r - toff[e] * 256;
        GAS u32x4* dst = (GAS u32x4*)(P.AG + (size_t)r * DM) + F.lane;
        if (pos < cnt[e]) { const int src = P.LIST[(size_t)e * T + pos]; const GAS u32x4* sp = (const GAS u32x4*)(P.H8 + (size_t)src * DM) + F.lane;
#pragma unroll
            for (int j = 0; j < 2; ++j) dst[64 * j] = sp[64 * j];
        } else {
#pragma unroll
            for (int j = 0; j < 2; ++j) dst[64 * j] = (u32x4){0u, 0u, 0u, 0u};
        }
    }
}
__device__ __forceinline__ void final_phase(const Frame& F, const Ptrs& P) {
    int toff[9], cnt[8]; moe_offsets(F, toff, cnt);
    pg8::MoeTailOrder TO; TO.init(toff[8], DM / 256, FE / 2, F.G, 0);
    const size_t split_row = (size_t)TO.nMf * 256; const int nparts = TO.S;
    const int gw = F.vcu * NWAVES + F.wave, NGW = F.G * NWAVES;
    for (int row = gw; row < T; row += NGW) {
        const u32x4 t4 = *(const GAS u32x4*)(P.TOK + (size_t)row * 8); const u32x2 gg = *(const GAS u32x2*)(P.TOK + (size_t)row * 8 + 4);
        int o1 = 0, o2 = 0;
#pragma unroll
        for (int e = 0; e < 8; ++e) { o1 = ((int)t4.x == e) ? toff[e] : o1; o2 = ((int)t4.z == e) ? toff[e] : o2; }
        const size_t r1 = (size_t)o1 * 256 + t4.y, r2 = (size_t)o2 * 256 + t4.w; const float g1 = __uint_as_float(gg.x), g2 = __uint_as_float(gg.y);
        const GAS u32x2* xr = (const GAS u32x2*)(P.X3 + (size_t)row * DM) + F.lane;
        const GAS u32x2* y1 = (const GAS u32x2*)(P.YB + r1 * DM) + F.lane; const GAS u32x2* y2 = (const GAS u32x2*)(P.YB + r2 * DM) + F.lane;
        f32x4 v[8]; float s = 0.f;
#pragma unroll
        for (int j = 0; j < 8; ++j) { const u32x2 a = y1[64 * j], b = y2[64 * j];
            const f32x4 ya = (f32x4){bf_lo(a.x), bf_hi(a.x), bf_lo(a.y), bf_hi(a.y)}, yb = (f32x4){bf_lo(b.x), bf_hi(b.x), bf_lo(b.y), bf_hi(b.y)};
            const u32x2 xa = xr[64 * j];
            v[j] = (f32x4){bf_lo(xa.x), bf_hi(xa.x), bf_lo(xa.y), bf_hi(xa.y)} + (ya * g1 + yb * g2); }
        if (nparts > 1 && (r1 >= split_row || r2 >= split_row)) {
            for (int p = 1; p < nparts; ++p) { const float h1 = (r1 >= split_row) ? g1 : 0.f, h2 = (r2 >= split_row) ? g2 : 0.f;
                const GAS u32x2* z1 = y1 + ((r1 >= split_row) ? (size_t)p * MOE_ROWS * DM / 4 : 0); const GAS u32x2* z2 = y2 + ((r2 >= split_row) ? (size_t)p * MOE_ROWS * DM / 4 : 0);
#pragma unroll
                for (int j = 0; j < 8; ++j) { const u32x2 a = z1[64 * j], b = z2[64 * j];
                    const f32x4 ya = (f32x4){bf_lo(a.x), bf_hi(a.x), bf_lo(a.y), bf_hi(a.y)}, yb = (f32x4){bf_lo(b.x), bf_hi(b.x), bf_lo(b.y), bf_hi(b.y)};
                    v[j] = v[j] + (ya * h1 + yb * h2); } } }
#pragma unroll
        for (int j = 0; j < 8; ++j) { s += (v[j].x * v[j].x + v[j].y * v[j].y) + (v[j].z * v[j].z + v[j].w * v[j].w); }
        const float rstd = 1.0f / sqrtf(wave_sum(s) * (1.0f / DM) + EPS);
        GAS f32x4* o = (GAS f32x4*)(P.out + (size_t)row * DM) + F.lane;
#pragma unroll
        for (int j = 0; j < 8; ++j) { const f32x4 gvv = *((const GAS f32x4*)P.ln_final + F.lane + 64 * j); o[64 * j] = v[j] * rstd * gvv; }
    }
}

constexpr int N_PHASES = 17;
struct Args { const float* in[14]; float* out; unsigned char* ws; int ph_lo, ph_hi; };
__global__ void __launch_bounds__(NWAVES * 64, 2) trunk_fwd(Args args) {
    extern __shared__ __attribute__((aligned(16))) unsigned char lds[];
#define PHASE_SETUP() Frame F; Ptrs P; { int t_ = wave0 * 64 + (int)__builtin_amdgcn_mbcnt_hi(~0u, __builtin_amdgcn_mbcnt_lo(~0u, 0u)); asm volatile("" : "+v"(t_)); \
    unsigned char* ws = args.ws; asm volatile("" : "+s"(ws)); \
    F.lds = (LAS unsigned char*)lds; F.tid = t_; F.lane = t_ & 63; F.wave = __builtin_amdgcn_readfirstlane(t_ >> 6); \
    F.G = gridDim.x; { const int bx = blockIdx.x; F.vcu = (F.G % 8 == 0) ? (bx % 8) * (F.G / 8) + bx / 8 : bx; } \
    F.ctl = (unsigned*)(ws + WS_CTL); \
    P.x = args.in[0]; P.ln_mix = args.in[1]; P.ln_ffn = args.in[2]; P.ln_final = args.in[3]; P.ret_w_in = args.in[4]; P.ret_w_out = args.in[5]; P.ffn_w_in = args.in[6]; P.ffn_w_out = args.in[7]; \
    P.att_w_in = args.in[8]; P.att_w_out = args.in[9]; P.rel_bias = args.in[10]; P.router = args.in[11]; P.moe_w_in = args.in[12]; P.moe_w_out = args.in[13]; P.out = args.out; \
    P.W_RIN = (bf16_t*)(ws + WS_W_RIN); P.W_ROUT = (bf16_t*)(ws + WS_W_ROUT); P.W_FIN = (bf16_t*)(ws + WS_W_FIN); P.W_FOUT = (bf16_t*)(ws + WS_W_FOUT); \
    P.W_AIN = (bf16_t*)(ws + WS_W_AIN); P.W_AOUT = (bf16_t*)(ws + WS_W_AOUT); P.W_MIN = ws + WS_W_MIN; P.W_MOUT = ws + WS_W_MOUT; \
    P.H = (bf16_t*)(ws + WS_H); P.PROJ = (bf16_t*)(ws + WS_A); P.ACT = (bf16_t*)(ws + WS_A); P.QKV = (bf16_t*)(ws + WS_A); P.ACT2 = ws + WS_A; P.H8 = ws + WS_H; \
    P.OB = (bf16_t*)(ws + WS_B); P.AO = (bf16_t*)(ws + WS_B); P.AO8 = ws + WS_B; P.AG = ws + WS_B; P.AGC = ws + WS_AGC; P.Y = (bf16_t*)(ws + WS_Y); \
    P.X1 = (bf16_t*)(ws + WS_X1); P.X2 = (bf16_t*)(ws + WS_X2); P.X3 = (bf16_t*)(ws + WS_X3); P.YB = (bf16_t*)(ws + WS_YB); P.SSP = (float*)(ws + WS_SSP); \
    P.LIST = (int*)(ws + WS_LIST); P.TOK = (unsigned*)(ws + WS_TOK); }
    LAS unsigned char* const lds3 = (LAS unsigned char*)lds;
    const int wave0 = __builtin_amdgcn_readfirstlane((int)threadIdx.x >> 6);
    unsigned* const ctl0 = (unsigned*)(args.ws + WS_CTL);
    for (int u = threadIdx.x; u < (LDS_BYTES - LDSCTL_OFF) / 4; u += NWAVES * 64) ((LAS unsigned*)(lds3 + LDSCTL_OFF))[u] = 0u;
    __syncthreads();
    volatile LAS unsigned* MISC = (volatile LAS unsigned*)(lds3 + MISC_OFF);
    XcdBarrier bar; bar.bar = ctl0 + CW_BAR; bar.x = 0; bar.st = nullptr;
    if (!MK_PER_PHASE) bar = xcd_barrier_post(ctl0 + CW_BAR, MISC + 8);
    const int lo = args.ph_lo, hi = args.ph_hi;
#ifndef PH_MASK
#define PH_MASK 0x1ffff
#endif
#define IN(k) (((PH_MASK >> (k)) & 1) && lo <= (k) && (k) < hi)
#define SEAM(k) do { if (IN(k) && IN((k) + 1)) xcd_barrier(bar); } while (0)

    if (IN(0)) { PHASE_SETUP(); LAS unsigned char* ring = F.lds; (void)ring; p0_prologue(F, P); if (DUP_MASK & 1) p0_prologue(F, P); } SEAM(0);
#if DBG_STAGE >= 1
    if (IN(1)) { PHASE_SETUP(); LAS unsigned char* ring = F.lds; (void)ring;
#if I8_RIN
        pg8::Gemm g{(const bf16_t*)P.H8, P.W_RIN, T, NRET, DM / 2, 0u, 0u, 0u}; pg8::StaticOrder S; S.init(T, NRET, DM / 2, F.G, (int)blockIdx.x); pg8::EpiRetInT<true> E{P.PROJ, NRET, I8_DESCALE};
        pg8::gemm_phase<pg8::EpiRetInT<true>, pg8::StaticOrder, true, true, false, true>(ring, F.tid, g, S, E);
#else
        pg8::Gemm g{P.H, P.W_RIN, T, NRET, DM, 0u, 0u, 0u}; pg8::StaticOrder S; S.init(T, NRET, DM, F.G, (int)blockIdx.x); pg8::EpiRetIn E{P.PROJ, NRET, 0.f};
        pg8::gemm_phase<pg8::EpiRetIn, pg8::StaticOrder, true, true>(ring, F.tid, g, S, E);
#endif
    } SEAM(1);
    if (IN(2)) { PHASE_SETUP(); LAS unsigned char* ring = F.lds; (void)ring; retention_phase(F, P); if (DUP_MASK & 4) retention_phase(F, P); } SEAM(2);
    if (IN(3)) { PHASE_SETUP(); LAS unsigned char* ring = F.lds; (void)ring; gate_phase(F, P); if (DUP_MASK & 8) gate_phase(F, P); } SEAM(3);
    if (IN(4)) { PHASE_SETUP(); LAS unsigned char* ring = F.lds; (void)ring; pg8::Gemm g{P.Y, P.W_ROUT, T, DM, RHV, 0u, 0u, 0u}; pg8::StaticOrder S; S.init(T, DM, RHV, F.G, (int)blockIdx.x); pg8::EpiResB<false> E{P.x, P.X1, DM};
        pg8::gemm_phase<pg8::EpiResB<false>, pg8::StaticOrder, true, true>(ring, F.tid, g, S, E); } SEAM(4);
#endif
#if DBG_STAGE >= 2
    if (IN(5)) { PHASE_SETUP(); LAS unsigned char* ring = F.lds; (void)ring; norm_rows_i8b(F, P.X1, P.ln_ffn, P.H8); if (DUP_MASK & 32) norm_rows_i8b(F, P.X1, P.ln_ffn, P.H8); } SEAM(5);
    if (IN(6)) { PHASE_SETUP(); LAS unsigned char* ring = F.lds; (void)ring; pg8::Gemm g{(const bf16_t*)P.H8, P.W_FIN, T, 2 * FF, DM / 2, 0u, 0u, 0u}; pg8::StaticOrder S; S.init(T, 2 * FF, DM / 2, F.G, (int)blockIdx.x);
#if F8_FOUT
        pg8::EpiSwiglu8T<true> E{(unsigned char*)P.ACT, FF, A2_SCALE, I8_DESCALE};
        pg8::gemm_phase<pg8::EpiSwiglu8T<true>, pg8::StaticOrder, true, true, false, true>(ring, F.tid, g, S, E); } SEAM(6);
#else
        pg8::EpiSwigluI E{P.ACT, FF, I8_DESCALE};
        pg8::gemm_phase<pg8::EpiSwigluI, pg8::StaticOrder, true, true, false, true>(ring, F.tid, g, S, E); } SEAM(6);
#endif
#if F8_FOUT
    if (IN(7)) { PHASE_SETUP(); LAS unsigned char* ring = F.lds; (void)ring; pg8::Gemm g{P.ACT, P.W_FOUT, T, DM, FF / 2, SB_W2, SB_A2, SB_W2}; pg8::StaticOrder S; S.init(T, DM, FF / 2, F.G, (int)blockIdx.x); pg8::EpiResB<true> E{P.X1, P.X2, DM};
        pg8::gemm_phase<pg8::EpiResB<true>, pg8::StaticOrder, true, true, true>(ring, F.tid, g, S, E); } SEAM(7);
#else
    if (IN(7)) { PHASE_SETUP(); LAS unsigned char* ring = F.lds; (void)ring; pg8::Gemm g{P.ACT, P.W_FOUT, T, DM, FF, 0u, 0u, 0u}; pg8::StaticOrder S; S.init(T, DM, FF, F.G, (int)blockIdx.x); pg8::EpiResB<true> E{P.X1, P.X2, DM};
        pg8::gemm_phase<pg8::EpiResB<true>, pg8::StaticOrder, true, true>(ring, F.tid, g, S, E); } SEAM(7);
#endif
#endif
#if DBG_STAGE >= 3
    if (IN(8)) { PHASE_SETUP(); LAS unsigned char* ring = F.lds; (void)ring; norm_rows_i8b(F, P.X2, P.ln_mix + DM, P.H8); if (DUP_MASK & 256) norm_rows_i8b(F, P.X2, P.ln_mix + DM, P.H8); } SEAM(8);
    if (IN(9)) { PHASE_SETUP(); LAS unsigned char* ring = F.lds; (void)ring; pg8::Gemm g{(const bf16_t*)P.H8, P.W_AIN, T, NATT, DM / 2, SB_W1, SB_H8, SB_W1}; pg8::StaticOrder S; S.init(T, NATT, DM / 2, F.G, (int)blockIdx.x);
#if I8_QKV
        pg8::EpiBf16T<true> E{P.QKV, NATT, 0, I8_DESCALE};
        pg8::gemm_phase<pg8::EpiBf16T<true>, pg8::StaticOrder, true, true, false, true>(ring, F.tid, g, S, E);
#else
        pg8::EpiBf16 E{P.QKV, NATT, 0, 0.f};
        pg8::gemm_phase<pg8::EpiBf16, pg8::StaticOrder, true, true, true>(ring, F.tid, g, S, E);
#endif
    } SEAM(9);
    if (IN(10)) { PHASE_SETUP(); LAS unsigned char* ring = F.lds; (void)ring; attention_phase(F, P); if (DUP_MASK & 1024) attention_phase(F, P); } SEAM(10);
    if (IN(11)) { PHASE_SETUP(); LAS unsigned char* ring = F.lds; (void)ring; pg8::Gemm g{(const bf16_t*)P.AO8, P.W_AOUT, T, DM, DM / 2, SB_W1, SB_H8, SB_W1}; pg8::StaticOrder S; S.init(T, DM, DM / 2, F.G, (int)blockIdx.x); pg8::EpiResB<true> E{P.X2, P.X3, DM};
        pg8::gemm_phase<pg8::EpiResB<true>, pg8::StaticOrder, true, true, true>(ring, F.tid, g, S, E); } SEAM(11);
#endif
#if DBG_STAGE >= 100
    if (IN(12)) { PHASE_SETUP(); LAS unsigned char* ring = F.lds; (void)ring; router_phase(F, P); } SEAM(12);
    if (IN(13)) {   }
    if (IN(14)) { PHASE_SETUP(); LAS unsigned char* ring = F.lds; (void)ring; int toff[9], cnt[8]; moe_offsets(F, toff, cnt);
        pg8::MoeOrder S; S.nM = toff[8]; S.nN = 2 * FE / 256; S.nwg = S.nM * S.nN; S.G = F.G; S.c = (int)blockIdx.x; S.nt0 = (DM / 2) / 64; S.aseg = T; S.estride = (unsigned)(2 * FE * DM);
#pragma unroll
        for (int e = 0; e < 9; ++e) S.toff[e] = toff[e];
        pg8::Gemm g{(const bf16_t*)P.AGC, (const bf16_t*)P.W_MIN, toff[8] * 256, 2 * FE, DM / 2, SB_W1, SB_H8, SB_W1U};
#if I8_MOE
        pg8::EpiSwiglu8T<true> E{P.ACT2, FE, A2_SCALE, I8_DESCALE};
        pg8::gemm_phase<pg8::EpiSwiglu8T<true>, pg8::MoeOrder, true, true, false, true>(ring, F.tid, g, S, E);
#else
        pg8::EpiSwiglu8 E{P.ACT2, FE, 1.0f, 0.f};
        pg8::gemm_phase<pg8::EpiSwiglu8, pg8::MoeOrder, true, true, true>(ring, F.tid, g, S, E);
#endif
    } SEAM(14);
    if (IN(15)) { PHASE_SETUP(); LAS unsigned char* ring = F.lds; (void)ring; int toff[9], cnt[8]; moe_offsets(F, toff, cnt);
        pg8::MoeTailOrder S; S.init(toff[8], DM / 256, FE / 2, F.G, (int)blockIdx.x); S.estride = (unsigned)(DM * FE);
#pragma unroll
        for (int e = 0; e < 9; ++e) S.toff[e] = toff[e];
        pg8::Gemm g{(const bf16_t*)P.ACT2, (const bf16_t*)P.W_MOUT, toff[8] * 256, DM, FE / 2, SB_W2, SB_A2, SB_W2}; pg8::EpiBf16 E{P.YB, DM, (size_t)MOE_ROWS * DM, 0.f};
        pg8::gemm_phase<pg8::EpiBf16, pg8::MoeTailOrder, true, true, true>(ring, F.tid, g, S, E); } SEAM(15);
    if (IN(16)) { PHASE_SETUP(); LAS unsigned char* ring = F.lds; (void)ring; final_phase(F, P); if (DUP_MASK & 65536) final_phase(F, P); }
#else
    if (IN(16)) { PHASE_SETUP(); LAS unsigned char* ring = F.lds; (void)ring; norm_rows_f32(F, P.x, P.ln_final, P.out); }
#endif
#undef IN
#undef SEAM
}

extern "C" void kernel_launch(void* const* d_in, const int* in_sizes, int n_in, void* d_out, int out_size, void* d_ws, size_t ws_size, hipStream_t stream) {
    static int grid = 0;
    if (grid == 0) {
        if (n_in != 14 || in_sizes[0] != T * DM || out_size != T * DM || ws_size < WS_END) { fprintf(stderr, "kernel_launch: shape mismatch (n_in %d in0 %d out %d ws %zu, need ws >= %zu)\n", n_in, n_in > 0 ? in_sizes[0] : -1, out_size, ws_size, (size_t)WS_END); grid = -1; return; }
        int dev = 0, cus = 0, per_cu = 0;
        if (hipGetDevice(&dev) != hipSuccess || hipDeviceGetAttribute(&cus, hipDeviceAttributeMultiprocessorCount, dev) != hipSuccess) { fprintf(stderr, "kernel_launch: device query failed\n"); grid = -1; return; }
        if (hipFuncSetAttribute((const void*)trunk_fwd, hipFuncAttributeMaxDynamicSharedMemorySize, LDS_BYTES) != hipSuccess) { fprintf(stderr, "kernel_launch: hipFuncSetAttribute failed\n"); grid = -1; return; }
        if (hipOccupancyMaxActiveBlocksPerMultiprocessor(&per_cu, (const void*)trunk_fwd, NWAVES * 64, LDS_BYTES) != hipSuccess || per_cu < 1)
            fprintf(stderr, "kernel_launch: note: occupancy query reports %d workgroups per CU\n", per_cu);
        (void)hipGetLastError();
        grid = cus;
    }
    if (grid < 0) return;
    if (hipMemsetAsync((char*)d_ws + WS_CTL, 0, CTL_ZERO_BYTES, stream) != hipSuccess) { fprintf(stderr, "kernel_launch: memset failed\n"); return; }
    Args a{};
    for (int i = 0; i < 14; ++i) a.in[i] = (const float*)d_in[i];
    a.out = (float*)d_out; a.ws = (unsigned char*)d_ws;
#if MK_PER_PHASE
    for (int ph = 0; ph < N_PHASES; ++ph) { a.ph_lo = ph; a.ph_hi = ph + 1; hipLaunchKernelGGL(trunk_fwd, dim3(grid), dim3(NWAVES * 64), LDS_BYTES, stream, a); }
#else
    a.ph_lo = 0; a.ph_hi = N_PHASES;
    hipLaunchKernelGGL(trunk_fwd, dim3(grid), dim3(NWAVES * 64), LDS_BYTES, stream, a);
#endif
    const hipError_t le = hipPeekAtLastError();
    if (le != hipSuccess) fprintf(stderr, "kernel_launch: launch failed: %s\n", hipGetErrorName(le));
}
```

```cpp
#include <hip/hip_runtime.h>
#include <cstdio>
#include <cstdint>

#ifndef DBG_STAGE
#define DBG_STAGE 100
#endif
#ifndef DUP_MASK
#define EPI_DUP 0
#define DUP_MASK 0
#endif
#ifndef I8_MOE
#define I8_MOE 1
#endif
#ifndef I8_QKV
#define I8_QKV 1
#endif
#ifndef I8_RIN
#define F8_FOUT 1
#define I8_RIN 1
#endif
#ifndef MK_PER_PHASE
#define MK_PER_PHASE 0
#endif

#define GAS __attribute__((address_space(1)))
#define LAS __attribute__((address_space(3)))
typedef unsigned short bf16_t;
typedef short bf16x8 __attribute__((ext_vector_type(8)));
typedef short s16x4 __attribute__((ext_vector_type(4)));
typedef float f32x4 __attribute__((ext_vector_type(4)));
typedef float f32x16 __attribute__((ext_vector_type(16)));
typedef unsigned u32x4 __attribute__((ext_vector_type(4)));
typedef unsigned u32x2 __attribute__((ext_vector_type(2)));

constexpr int DM = 2048, NBATCH = 8, SEQ = 2048, T = NBATCH * SEQ, CHUNK = 64;
constexpr int RH = 8, RDK = 256, RDV = 512, RHV = RH * RDV, NRET = 2 * DM + 2 * RHV;
constexpr int AH = 16, AD = 128, NATT = 3 * DM;
constexpr int FF = 5632, NE = 8, FE = 7168;
constexpr int MOE_ROWS = 2 * T + NE * 256;
constexpr float EPS = 1e-6f;
constexpr float LOG2E = 1.4426950408889634f;
constexpr int NWAVES = 8;
constexpr float H8_SCALE = 32.f, W1_SCALE = 1024.f, A2_SCALE = 4.f, W2_SCALE = 2048.f;
constexpr float HI8_SCALE = 127.f / 4.f, WI8_SCALE = 127.f * 45.254833995939045f / 4.f, I8_DESCALE = 1.0f / (HI8_SCALE * WI8_SCALE);
constexpr unsigned SB_H8 = 0x7a7a7a7au  , SB_W1 = 0x75757575u  , SB_A2 = 0x7d7d7d7du  , SB_W2 = 0x74747474u  , SB_W1U = 0x77777777u  ;

constexpr size_t MiB = 1u << 20;
constexpr size_t WS_CTL = 0, CTL_ZERO_BYTES = 1 * MiB;
constexpr size_t WS_W_RIN = 2 * MiB, WS_W_ROUT = 50 * MiB, WS_W_FIN = 66 * MiB, WS_W_FOUT = 110 * MiB, WS_W_AIN = 132 * MiB, WS_W_AOUT = 156 * MiB;
constexpr size_t WS_W_MIN = 164 * MiB, WS_W_MOUT = 612 * MiB;
constexpr size_t WS_H = 836 * MiB;
constexpr size_t WS_A = 900 * MiB;
constexpr size_t WS_B = 1376 * MiB;
constexpr size_t WS_Y = 1512 * MiB;
constexpr size_t WS_X1 = 1640 * MiB, WS_X2 = 1768 * MiB, WS_X3 = 1896 * MiB;
constexpr size_t WS_YB = 2300 * MiB;
constexpr size_t WS_SSP = 2296 * MiB;
constexpr size_t WS_LIST = 2298 * MiB;
constexpr size_t WS_TOK = 2299 * MiB;
constexpr size_t WS_AGC = 2300 * MiB + 4 * 136 * MiB;
constexpr size_t WS_END = WS_AGC + 256 * MiB;
constexpr int CW_TMO = 0, CW_BAR = 4096, CW_CNT = 8192;

constexpr int RING_BYTES = 143360;
static_assert(8 * 16640 <= RING_BYTES && 131072 <= RING_BYTES, "phase scratch must stay below the LDS control words");
constexpr int LDSCTL_OFF = RING_BYTES, MISC_OFF = LDSCTL_OFF + 320;
constexpr int LDS_BYTES = 147456;

#define LDS_WAIT() asm volatile("s_waitcnt lgkmcnt(0)" ::: "memory")
#define VM_WAIT() asm volatile("s_waitcnt vmcnt(0)" ::: "memory")
#define RLX_AGENT __ATOMIC_RELAXED, __HIP_MEMORY_SCOPE_AGENT

__device__ __forceinline__ unsigned cvt_pk_bf16(float lo, float hi) { unsigned r; asm volatile("v_cvt_pk_bf16_f32 %0, %1, %2" : "=v"(r) : "v"(lo), "v"(hi)); return r; }
__device__ __forceinline__ float bf_lo(unsigned w) { return __uint_as_float(w << 16); }
__device__ __forceinline__ float bf_hi(unsigned w) { return __uint_as_float(w & 0xffff0000u); }
__device__ __forceinline__ float silu_f(float x) { return x * __builtin_amdgcn_rcpf(1.0f + __builtin_amdgcn_exp2f(-x * LOG2E)); }
__device__ __forceinline__ unsigned pk4_i8(float a, float b, float c, float d, float sc) {
    const int ia = (int)__builtin_rintf(__builtin_amdgcn_fmed3f(a * sc, -127.f, 127.f)), ib = (int)__builtin_rintf(__builtin_amdgcn_fmed3f(b * sc, -127.f, 127.f));
    const int ic = (int)__builtin_rintf(__builtin_amdgcn_fmed3f(c * sc, -127.f, 127.f)), id = (int)__builtin_rintf(__builtin_amdgcn_fmed3f(d * sc, -127.f, 127.f));
    return ((unsigned)ia & 0xffu) | (((unsigned)ib & 0xffu) << 8) | (((unsigned)ic & 0xffu) << 16) | ((unsigned)id << 24);
}
__device__ __forceinline__ float wave_sum(float v) {
    v += __builtin_bit_cast(float, __builtin_amdgcn_update_dpp(0, __builtin_bit_cast(int, v), 0xB1, 0xf, 0xf, true));
    v += __builtin_bit_cast(float, __builtin_amdgcn_update_dpp(0, __builtin_bit_cast(int, v), 0x4E, 0xf, 0xf, true));
    v += __builtin_bit_cast(float, __builtin_amdgcn_update_dpp(0, __builtin_bit_cast(int, v), 0x141, 0xf, 0xf, true));
    v += __builtin_bit_cast(float, __builtin_amdgcn_update_dpp(0, __builtin_bit_cast(int, v), 0x140, 0xf, 0xf, true));
    const int vi = __builtin_bit_cast(int, v);
    return (__builtin_bit_cast(float, __builtin_amdgcn_readlane(vi, 0)) + __builtin_bit_cast(float, __builtin_amdgcn_readlane(vi, 16)))
         + (__builtin_bit_cast(float, __builtin_amdgcn_readlane(vi, 32)) + __builtin_bit_cast(float, __builtin_amdgcn_readlane(vi, 48)));
}

namespace pg8 {
typedef int v4i32 __attribute__((ext_vector_type(4)));
constexpr int BM = 256, BK = 64, HALF = 128, HTB = HALF * BK * 2, STAGE_BYTES = 8 * HTB, NXCD = 8, WGM = 4;
__host__ __device__ __forceinline__ int lds_byte(int r, int c) { const int st = (r >> 4) * 2 + (c >> 5), rr = r & 15, cc = c & 31, ob = rr * 64 + cc * 2; return st * 1024 + (ob ^ (((ob >> 9) & 1) << 5)); }
__host__ __device__ __forceinline__ void stage_rc(int b, int& R, int& C) { const int st = b / 1024, sb = b % 1024, swz = sb ^ (((sb >> 9) & 1) << 5); R = (st >> 1) * 16 + swz / 64; C = (st & 1) * 32 + (swz % 64) / 2; }
__host__ __device__ __forceinline__ int perm32(int rho) { const int n = rho >> 4, i = rho & 15; return 8 * (i >> 2) + 4 * n + (i & 3); }

struct Unit { int pm, pn; unsigned boff; unsigned koff; int nt, part, arow; };
struct Gemm { const bf16_t* A; const bf16_t* Bt; int M, N, K; unsigned sW, sA, sWu; };

struct StaticOrder {
    int nM, nN, nwg, G, c, nt0;
    __device__ __forceinline__ void init(int M, int N, int K, int G_, int c_) { nM = M / BM; nN = N / BM; nwg = nM * nN; G = G_; c = c_; nt0 = K / BK; }
    __device__ __forceinline__ bool next(int i, Unit& u) const {
        const long L = (long)i * G + c; if (L >= nwg) return false;
        int wgid = (int)L; { const int q = nwg / NXCD, r = nwg % NXCD, xcd = wgid % NXCD, off = wgid / NXCD; wgid = (xcd < r ? xcd * (q + 1) : r * (q + 1) + (xcd - r) * q) + off; }
        const int nig = WGM * nN, gid = wgid / nig, fm = gid * WGM, gsz = (nM - fm) < WGM ? (nM - fm) : WGM;
        u.pm = fm + ((wgid % nig) % gsz); u.pn = (wgid % nig) / gsz; u.boff = 0; u.koff = 0; u.nt = nt0; u.part = 0; u.arow = u.pm * BM; return true;
    }
    __device__ __forceinline__ void a_ready(const Unit&) const {}
    __device__ __forceinline__ void done(const Unit&) const {}
};
struct MoeOrder {
    int nM, nN, nwg, G, c, nt0, aseg; int toff[9]; unsigned estride;
    __device__ __forceinline__ bool next(int i, Unit& u) const {
        const long L = (long)i * G + c; if (L >= nwg) return false;
        int wgid = (int)L; { const int q = nwg / NXCD, r = nwg % NXCD, xcd = wgid % NXCD, off = wgid / NXCD; wgid = (xcd < r ? xcd * (q + 1) : r * (q + 1) + (xcd - r) * q) + off; }
        const int CG = nN / NXCD, nig = CG * nM, gid = wgid / nig, fn = gid * CG;
        u.pn = fn + ((wgid % nig) % CG); u.pm = (wgid % nig) / CG;
        int e = 0;
#pragma unroll
        for (int j = 1; j < 8; ++j) e += (u.pm >= toff[j]) ? 1 : 0;
        u.boff = (unsigned)e * estride; u.koff = 0; u.nt = nt0; u.part = 0; { int te = 0;
#pragma unroll
          for (int j = 1; j < 8; ++j) te = (u.pm >= toff[j]) ? toff[j] : te;
          u.arow = e * aseg + (u.pm - te) * BM; } return true;
    }
    __device__ __forceinline__ void a_ready(const Unit&) const {}
    __device__ __forceinline__ void done(const Unit&) const {}
};

struct MoeTailOrder {
    int nM, nMf, nN, G, c, nt0, S; int toff[9]; unsigned estride;
    __device__ __forceinline__ void init(int nM_, int nN_, int K, int G_, int c_) { nM = nM_; nN = nN_; G = G_; c = c_; nt0 = K / BK;
        const int nwg = nM * nN, rem = nwg % G; S = (rem == 0 || rem * 2 > G) ? 1 : (rem * 4 > G ? 2 : 4); nMf = (S == 1) ? nM : nM - rem / nN; }
    __device__ __forceinline__ bool next(int i, Unit& u) const {
        const int nfull = nMf * nN; const int L = i * G + c;
        int pm, pn, nt, part; unsigned koff;
        if (L < nfull) {
            int wgid = L; { const int q = nfull / NXCD, r = nfull % NXCD, xcd = wgid % NXCD, off = wgid / NXCD; wgid = (xcd < r ? xcd * (q + 1) : r * (q + 1) + (xcd - r) * q) + off; }
            const int nig = WGM * nN, gid = wgid / nig, fm = gid * WGM, gsz = (nMf - fm) < WGM ? (nMf - fm) : WGM;
            pm = fm + ((wgid % nig) % gsz); pn = (wgid % nig) / gsz; koff = 0u; nt = nt0; part = 0;
        } else {
            const int j = L - nfull, ntail = (nM - nMf) * nN;
            if (j >= ntail * S) return false;
            const int tu = j / S, p = j - tu * S;
            pm = nMf + tu / nN; pn = tu % nN; nt = nt0 / S; koff = (unsigned)(p * nt * BK * 2); part = p;
        }
        int e = 0;
        e += (pm >= toff[1]) ? 1 : 0; e += (pm >= toff[2]) ? 1 : 0; e += (pm >= toff[3]) ? 1 : 0; e += (pm >= toff[4]) ? 1 : 0; e += (pm >= toff[5]) ? 1 : 0; e += (pm >= toff[6]) ? 1 : 0; e += (pm >= toff[7]) ? 1 : 0;
        u.pm = pm; u.pn = pn; u.boff = (unsigned)e * estride; u.koff = koff; u.nt = nt; u.part = part; u.arow = pm * BM; return true;
    }
    __device__ __forceinline__ void a_ready(const Unit&) const {}
    __device__ __forceinline__ void done(const Unit&) const {}
};
template <bool INT> __device__ __forceinline__ f32x4 accv(const f32x4& a, float dsc) { if constexpr (INT) return __builtin_convertvector(__builtin_bit_cast(v4i32, a), f32x4) * dsc; else return a; }
template <bool INT> struct EpiBf16T {
    static constexpr bool PERM = true, AFTER_DRAIN = false;
    bf16_t* O; int ldc; size_t pstride; float dsc;
    __device__ __forceinline__ void operator()(const f32x4 (&acc)[2][2][4][2], const Unit& u, int wr, int wc, int fr, int fq) const {
        const unsigned lo = (unsigned)((wr * 64 + fr) * ldc + u.pn * BM + wc * 32 + 8 * fq);
#pragma unroll
        for (int ai = 0; ai < 2; ++ai)
#pragma unroll
            for (int m = 0; m < 4; ++m) { bf16_t* rb = O + (size_t)u.part * pstride + (size_t)(u.pm * BM + ai * HALF + m * 16) * ldc;
#pragma unroll
                for (int bj = 0; bj < 2; ++bj) { const f32x4 v0 = accv<INT>(acc[ai][bj][m][0], dsc), v1 = accv<INT>(acc[ai][bj][m][1], dsc);
                    u32x4 w; w.x = cvt_pk_bf16(v0[0], v0[1]); w.y = cvt_pk_bf16(v0[2], v0[3]); w.z = cvt_pk_bf16(v1[0], v1[1]); w.w = cvt_pk_bf16(v1[2], v1[3]);
                    *(u32x4*)(rb + lo + bj * HALF) = w; } }
    }
};
typedef EpiBf16T<false> EpiBf16;
template <bool INT> struct EpiRetInT {
    static constexpr bool PERM = true, AFTER_DRAIN = false;
    bf16_t* O; int ldc; float dsc;
    __device__ __forceinline__ void operator()(const f32x4 (&acc)[2][2][4][2], const Unit& u, int wr, int wc, int fr, int fq) const {
        const int row0 = u.pm * BM + wr * 64 + fr;
        const unsigned lo = (unsigned)((wr * 64 + fr) * ldc + u.pn * BM + wc * 32 + 8 * fq);
        if (u.pn < 16) {
            const float ksc = (u.pn >= 8) ? 0.0625f : 1.0f;
            float rf[2][4];
#pragma unroll
            for (int n = 0; n < 2; ++n)
#pragma unroll
                for (int e = 0; e < 4; ++e) { const float d = (float)(wc * 32 + 8 * fq + 4 * n + e);
                    rf[n][e] = __builtin_amdgcn_exp2f(d * (-13.287712379549449f / 128.0f)) * 0.15915494309189535f; }
#pragma unroll
            for (int ai = 0; ai < 2; ++ai)
#pragma unroll
                for (int m = 0; m < 4; ++m) { const int row = row0 + ai * HALF + m * 16; const float pos = (float)(row & (SEQ - 1));
                    bf16_t* rowp = O + (size_t)(u.pm * BM + ai * HALF + m * 16) * ldc + lo;
                    f32x4 o1[2], o2[2];
#pragma unroll
                    for (int n = 0; n < 2; ++n) { const f32x4 x1 = accv<INT>(acc[ai][0][m][n], dsc), x2 = accv<INT>(acc[ai][1][m][n], dsc);
#pragma unroll
                        for (int e = 0; e < 4; ++e) { const float ph = __builtin_amdgcn_fractf(pos * rf[n][e]);
                            const float sn = __builtin_amdgcn_sinf(ph), cs = __builtin_amdgcn_cosf(ph);
                            o1[n][e] = (x1[e] * cs - x2[e] * sn) * ksc; o2[n][e] = (x1[e] * sn + x2[e] * cs) * ksc; } }
                    u32x4 w; w.x = cvt_pk_bf16(o1[0][0], o1[0][1]); w.y = cvt_pk_bf16(o1[0][2], o1[0][3]); w.z = cvt_pk_bf16(o1[1][0], o1[1][1]); w.w = cvt_pk_bf16(o1[1][2], o1[1][3]);
                    *(u32x4*)(rowp) = w;
                    w.x = cvt_pk_bf16(o2[0][0], o2[0][1]); w.y = cvt_pk_bf16(o2[0][2], o2[0][3]); w.z = cvt_pk_bf16(o2[1][0], o2[1][1]); w.w = cvt_pk_bf16(o2[1][2], o2[1][3]);
                    *(u32x4*)(rowp + HALF) = w; }
        } else {
#pragma unroll
            for (int ai = 0; ai < 2; ++ai)
#pragma unroll
                for (int m = 0; m < 4; ++m) { bf16_t* rb = O + (size_t)(u.pm * BM + ai * HALF + m * 16) * ldc;
#pragma unroll
                    for (int bj = 0; bj < 2; ++bj) { const f32x4 v0 = accv<INT>(acc[ai][bj][m][0], dsc), v1 = accv<INT>(acc[ai][bj][m][1], dsc);
                        u32x4 w; w.x = cvt_pk_bf16(v0[0], v0[1]); w.y = cvt_pk_bf16(v0[2], v0[3]); w.z = cvt_pk_bf16(v1[0], v1[1]); w.w = cvt_pk_bf16(v1[2], v1[3]);
                        *(u32x4*)(rb + lo + bj * HALF) = w; } }
        }
    }
};
typedef EpiRetInT<false> EpiRetIn;
struct EpiSwiglu {
    static constexpr bool PERM = true, AFTER_DRAIN = false;
    bf16_t* O; int ldc;
    __device__ __forceinline__ void operator()(const f32x4 (&acc)[2][2][4][2], const Unit& u, int wr, int wc, int fr, int fq) const {
        const unsigned lo = (unsigned)((wr * 64 + fr) * ldc + u.pn * HALF + wc * 32 + 8 * fq);
#pragma unroll
        for (int ai = 0; ai < 2; ++ai)
#pragma unroll
            for (int m = 0; m < 4; ++m) { bf16_t* rowp = O + (size_t)(u.pm * BM + ai * HALF + m * 16) * ldc + lo;
                f32x4 v[2];
#pragma unroll
                for (int n = 0; n < 2; ++n) { const f32x4 g = acc[ai][0][m][n], uu = acc[ai][1][m][n];
                    const f32x4 t = g * (-LOG2E); f32x4 d;
#pragma unroll
                    for (int e = 0; e < 4; ++e) d[e] = __builtin_amdgcn_exp2f(t[e]);
                    d = d + 1.0f;
#pragma unroll
                    for (int e = 0; e < 4; ++e) d[e] = __builtin_amdgcn_rcpf(d[e]);
                    v[n] = (g * uu) * d; }
                u32x4 w; w.x = cvt_pk_bf16(v[0][0], v[0][1]); w.y = cvt_pk_bf16(v[0][2], v[0][3]); w.z = cvt_pk_bf16(v[1][0], v[1][1]); w.w = cvt_pk_bf16(v[1][2], v[1][3]);
                *(u32x4*)(rowp) = w; }
    }
};
struct EpiSwigluI {
    static constexpr bool PERM = true, AFTER_DRAIN = false;
    bf16_t* O; int ldc; float dsc;
    __device__ __forceinline__ void operator()(const f32x4 (&acc)[2][2][4][2], const Unit& u, int wr, int wc, int fr, int fq) const {
        const unsigned lo = (unsigned)((wr * 64 + fr) * ldc + u.pn * HALF + wc * 32 + 8 * fq);
#pragma unroll
        for (int ai = 0; ai < 2; ++ai)
#pragma unroll
            for (int m = 0; m < 4; ++m) { bf16_t* rowp = O + (size_t)(u.pm * BM + ai * HALF + m * 16) * ldc + lo;
                f32x4 v[2];
#pragma unroll
                for (int n = 0; n < 2; ++n) { const f32x4 g = __builtin_convertvector(__builtin_bit_cast(v4i32, acc[ai][0][m][n]), f32x4), uu = __builtin_convertvector(__builtin_bit_cast(v4i32, acc[ai][1][m][n]), f32x4);
                    const f32x4 t = g * (-LOG2E * dsc); f32x4 d;
#pragma unroll
                    for (int e = 0; e < 4; ++e) d[e] = __builtin_amdgcn_exp2f(t[e]);
                    d = d + 1.0f;
#pragma unroll
                    for (int e = 0; e < 4; ++e) d[e] = __builtin_amdgcn_rcpf(d[e]);
                    v[n] = (g * uu) * (d * (dsc * dsc)); }
                u32x4 w; w.x = cvt_pk_bf16(v[0][0], v[0][1]); w.y = cvt_pk_bf16(v[0][2], v[0][3]); w.z = cvt_pk_bf16(v[1][0], v[1][1]); w.w = cvt_pk_bf16(v[1][2], v[1][3]);
                *(u32x4*)(rowp) = w; }
    }
};
template <bool INT> struct EpiSwiglu8T {
    static constexpr bool PERM = true, AFTER_DRAIN = false;
    unsigned char* O; int ldc; float oscale, dsc;
    __device__ __forceinline__ void operator()(const f32x4 (&acc)[2][2][4][2], const Unit& u, int wr, int wc, int fr, int fq) const {
        const unsigned lo = (unsigned)((wr * 64 + fr) * ldc + u.pn * HALF + wc * 32 + 8 * fq);
#pragma unroll
        for (int ai = 0; ai < 2; ++ai)
#pragma unroll
            for (int m = 0; m < 4; ++m) { unsigned char* rowp = O + (size_t)(u.pm * BM + ai * HALF + m * 16) * ldc + lo;
                f32x4 v[2];
#pragma unroll
                for (int n = 0; n < 2; ++n) {
                    const f32x4 g = INT ? __builtin_convertvector(__builtin_bit_cast(v4i32, acc[ai][0][m][n]), f32x4) : acc[ai][0][m][n];
                    const f32x4 uu = INT ? __builtin_convertvector(__builtin_bit_cast(v4i32, acc[ai][1][m][n]), f32x4) : acc[ai][1][m][n];
                    const float k1 = INT ? -LOG2E * dsc : -LOG2E, k2 = INT ? dsc * dsc * oscale : oscale;
                    const f32x4 t = g * k1; f32x4 d;
#pragma unroll
                    for (int e = 0; e < 4; ++e) d[e] = __builtin_amdgcn_exp2f(t[e]);
                    d = d + 1.0f;
#pragma unroll
                    for (int e = 0; e < 4; ++e) d[e] = __builtin_amdgcn_rcpf(d[e]);
                    const f32x4 o = (g * uu) * (d * k2);
#pragma unroll
                    for (int e = 0; e < 4; ++e) v[n][e] = __builtin_amdgcn_fmed3f(o[e], -448.f, 448.f); }
                u32x2 w; int t = 0;
                t = __builtin_amdgcn_cvt_pk_fp8_f32(v[0][0], v[0][1], t, false); t = __builtin_amdgcn_cvt_pk_fp8_f32(v[0][2], v[0][3], t, true); w.x = (unsigned)t;
                t = __builtin_amdgcn_cvt_pk_fp8_f32(v[1][0], v[1][1], t, false); t = __builtin_amdgcn_cvt_pk_fp8_f32(v[1][2], v[1][3], t, true); w.y = (unsigned)t;
                *(u32x2*)(rowp) = w; }
    }
};
typedef EpiSwiglu8T<false> EpiSwiglu8;
struct EpiResF32 {
    static constexpr bool PERM = false, AFTER_DRAIN = false;
    const float* base; float* out; int ldc;
    __device__ __forceinline__ void operator()(const f32x4 (&acc)[2][2][4][2], const Unit& u, int wr, int wc, int fr, int fq) const {
        const unsigned lo = (unsigned)((wr * 64 + fr) * ldc + u.pn * BM + wc * 32 + 4 * fq);
#pragma unroll
        for (int ai = 0; ai < 2; ++ai)
#pragma unroll
            for (int m = 0; m < 4; ++m) { const size_t rg = (size_t)(u.pm * BM + ai * HALF + m * 16) * ldc;
#pragma unroll
                for (int bj = 0; bj < 2; ++bj)
#pragma unroll
                    for (int n = 0; n < 2; ++n) { f32x4 o = acc[ai][bj][m][n]; if (base) o = o + *(const f32x4*)(base + rg + lo + bj * HALF + n * 16);
                        *(f32x4*)(out + rg + lo + bj * HALF + n * 16) = o; } }
    }
};

template <bool BASE_BF16> struct EpiResB {
    static constexpr bool PERM = true, AFTER_DRAIN = false;
    const void* base; bf16_t* out; int ldc;
    __device__ __forceinline__ void operator()(const f32x4 (&acc)[2][2][4][2], const Unit& u, int wr, int wc, int fr, int fq) const {
        const unsigned lo = (unsigned)((wr * 64 + fr) * ldc + u.pn * BM + wc * 32 + 8 * fq);
#pragma unroll
        for (int ai = 0; ai < 2; ++ai)
#pragma unroll
            for (int m = 0; m < 4; ++m) { const size_t rg = (size_t)(u.pm * BM + ai * HALF + m * 16) * ldc;
#pragma unroll
                for (int bj = 0; bj < 2; ++bj) { f32x4 v0 = acc[ai][bj][m][0], v1 = acc[ai][bj][m][1];
                    if constexpr (BASE_BF16) { const u32x4 b = *(const u32x4*)((const bf16_t*)base + rg + lo + bj * HALF);
                        v0 = v0 + (f32x4){bf_lo(b.x), bf_hi(b.x), bf_lo(b.y), bf_hi(b.y)}; v1 = v1 + (f32x4){bf_lo(b.z), bf_hi(b.z), bf_lo(b.w), bf_hi(b.w)}; }
                    else { const float* bp = (const float*)base + rg + lo + bj * HALF; v0 = v0 + *(const f32x4*)bp; v1 = v1 + *(const f32x4*)(bp + 4); }
                    u32x4 w; w.x = cvt_pk_bf16(v0[0], v0[1]); w.y = cvt_pk_bf16(v0[2], v0[3]); w.z = cvt_pk_bf16(v1[0], v1[1]); w.w = cvt_pk_bf16(v1[2], v1[3]);
                    *(u32x4*)(out + rg + lo + bj * HALF) = w; } }
    }
};

typedef int v8i32 __attribute__((ext_vector_type(8)));
template <class Epi, class Sched, bool ALIGN_EPI = false, bool SP2 = false, bool F8 = false, bool I8 = false>
__device__ __forceinline__ void gemm_phase(LAS unsigned char* lds, const int tid, const Gemm g, const Sched& S, const Epi& E) {
    const int wid = __builtin_amdgcn_readfirstlane(tid >> 6), lane = tid & 63, wr = wid >> 2, wc = wid & 3, fr = lane & 15, fq = lane >> 4;
    const int K = g.K;
    unsigned voffA[2], voffB[2];
#pragma unroll
    for (int i = 0; i < 2; ++i) { int R, C; stage_rc(tid * 16 + i * 8192, R, C); const int Rb = Epi::PERM ? ((R & ~31) + perm32(R & 31)) : R;
        voffA[i] = (unsigned)(R * K + C) * 2u; voffB[i] = (unsigned)(Rb * K + C) * 2u; }
    const __amdgpu_buffer_rsrc_t rsA = __builtin_amdgcn_make_buffer_rsrc((void*)g.A, 0, 0xffffffff, 0x00020000);
    const __amdgpu_buffer_rsrc_t rsB = __builtin_amdgcn_make_buffer_rsrc((void*)g.Bt, 0, 0xffffffff, 0x00020000);
    const int kstep = BK * 2;
    const int hstep = HALF * K * 2;
    const int tstep = 2 * hstep;
    const unsigned ldsw = (unsigned)wid * 1024u;
    const int aoff = lds_byte(wr * 64 + fr, fq * 8), boff = lds_byte(wc * 32 + fr, fq * 8);
#define PG8_SA(b, h) (((b) * 2 + (h)) * HTB)
#define PG8_SB(b, h) ((4 + (b) * 2 + (h)) * HTB)
#define PG8_RS_voffA rsA
#define PG8_RS_voffB rsB
#define PG8_STAGE(bufoff, soff, voff) do { _Pragma("unroll") for (int _i = 0; _i < 2; ++_i) \
        __builtin_amdgcn_raw_ptr_buffer_load_lds(PG8_RS_##voff, (LAS void*)(lds + (bufoff) + ldsw + _i * 8192), 16, (int)(voff)[_i], (int)(soff), 0, 0); } while (0)
#define PG8_LD8(p) __builtin_bit_cast(v8i32, __builtin_shufflevector(*(const LAS u32x4*)(p), *(const LAS u32x4*)((p) + 1024), 0, 1, 2, 3, 4, 5, 6, 7))
#define PG8_LDA(dst, b, h) do { if constexpr (F8) { _Pragma("unroll") for (int m = 0; m < 4; ++m) dst##8[m] = PG8_LD8(lds + PG8_SA(b, h) + aoff + m * 2048); } \
        else { _Pragma("unroll") for (int m = 0; m < 4; ++m) _Pragma("unroll") for (int k = 0; k < 2; ++k) dst[m][k] = *(const LAS bf16x8*)(lds + PG8_SA(b, h) + aoff + m * 2048 + k * 1024); } } while (0)
#define PG8_LDB(dst, b, h) do { if constexpr (F8) { _Pragma("unroll") for (int n = 0; n < 2; ++n) dst##8[n] = PG8_LD8(lds + PG8_SB(b, h) + boff + n * 2048); } \
        else { _Pragma("unroll") for (int n = 0; n < 2; ++n) _Pragma("unroll") for (int k = 0; k < 2; ++k) dst[n][k] = *(const LAS bf16x8*)(lds + PG8_SB(b, h) + boff + n * 2048 + k * 1024); } } while (0)
#define PG8_MMA(ai, bj, At, Bt) do { __builtin_amdgcn_s_setprio(1); \
        if constexpr (F8) { _Pragma("unroll") for (int m = 0; m < 4; ++m) _Pragma("unroll") for (int n = 0; n < 2; ++n) \
            asm volatile("v_mfma_scale_f32_16x16x128_f8f6f4 %0, %1, %2, %0, %3, %4 op_sel_hi:[0,0,0]" : "+v"(acc[ai][bj][m][n]) : "v"(Bt##8[n]), "v"(At##8[m]), "v"((bj) ? g.sWu : g.sW), "v"(g.sA)); } \
        else if constexpr (I8) { _Pragma("unroll") for (int m = 0; m < 4; ++m) _Pragma("unroll") for (int n = 0; n < 2; ++n) _Pragma("unroll") for (int k = 0; k < 2; ++k) \
            acc[ai][bj][m][n] = __builtin_bit_cast(f32x4, __builtin_amdgcn_mfma_i32_16x16x64_i8(__builtin_bit_cast(v4i32, Bt[n][k]), __builtin_bit_cast(v4i32, At[m][k]), __builtin_bit_cast(v4i32, acc[ai][bj][m][n]), 0, 0, 0)); } \
        else { _Pragma("unroll") for (int m = 0; m < 4; ++m) _Pragma("unroll") for (int n = 0; n < 2; ++n) _Pragma("unroll") for (int k = 0; k < 2; ++k) \
            acc[ai][bj][m][n] = __builtin_amdgcn_mfma_f32_16x16x32_bf16(Bt[n][k], At[m][k], acc[ai][bj][m][n], 0, 0, 0); } \
        __builtin_amdgcn_s_setprio(0); } while (0)
#define PG8_WAIT_V(n) asm volatile("s_waitcnt vmcnt(" #n ")" ::: "memory")
#define PG8_WAIT_L(n) asm volatile("s_waitcnt lgkmcnt(" #n ")" ::: "memory")
#define PG8_BAR __builtin_amdgcn_s_barrier()
#define PG8_SCHED __builtin_amdgcn_sched_barrier(0)
    Unit cur, nxt; int ui = 0;
    if (!S.next(0, cur)) return;
    f32x4 acc[2][2][4][2];
#pragma unroll
    for (int a = 0; a < 2; ++a)
#pragma unroll
        for (int b = 0; b < 2; ++b)
#pragma unroll
            for (int m = 0; m < 4; ++m)
#pragma unroll
                for (int n = 0; n < 2; ++n) acc[a][b][m][n] = (f32x4){0.f, 0.f, 0.f, 0.f};
    bf16x8 At[4][2], B0[2][2], B1[2][2]; v8i32 At8[4], B08[2], B18[2];
    const int rstep = K * 2;
    int cA = cur.arow * rstep + (int)cur.koff; int cB = (int)cur.boff + cur.pn * tstep + (int)cur.koff;
    S.a_ready(cur);
    if constexpr (SP2) {
        PG8_STAGE(PG8_SB(0, 0), cB, voffB); PG8_STAGE(PG8_SB(0, 1), cB + hstep, voffB); PG8_STAGE(PG8_SA(0, 0), cA, voffA); PG8_STAGE(PG8_SA(0, 1), cA + hstep, voffA);
        if (wr == 1) PG8_BAR;
        PG8_WAIT_V(2); PG8_BAR;
        PG8_STAGE(PG8_SB(1, 0), cB + kstep, voffB); PG8_STAGE(PG8_SA(1, 0), cA + kstep, voffA); PG8_STAGE(PG8_SB(1, 1), cB + hstep + kstep, voffB);
        PG8_WAIT_V(6); PG8_BAR;
    } else {
        PG8_STAGE(PG8_SB(0, 0), cB, voffB); PG8_STAGE(PG8_SA(0, 0), cA, voffA); PG8_STAGE(PG8_SB(0, 1), cB + hstep, voffB); PG8_STAGE(PG8_SA(0, 1), cA + hstep, voffA);
        if (wr == 1) PG8_BAR;
        PG8_WAIT_V(4); PG8_BAR;
        PG8_STAGE(PG8_SB(1, 0), cB + kstep, voffB); PG8_STAGE(PG8_SA(1, 0), cA + kstep, voffA); PG8_STAGE(PG8_SB(1, 1), cB + hstep + kstep, voffB);
        PG8_WAIT_V(6); PG8_BAR;
    }
    for (;;) {
        const bool has_next = S.next(ui + 1, nxt);
        const int nA = has_next ? nxt.arow * rstep + (int)nxt.koff : cA; const int nB = has_next ? (int)nxt.boff + nxt.pn * tstep + (int)nxt.koff : cB;
        const int nt = cur.nt;
        for (int t = 0; t < nt; t += 2) {
            const bool last = (t == nt - 2);
            const int a1 = cA + (t + 1) * kstep;
            const int a2 = last ? nA : cA + (t + 2) * kstep; const int b2 = last ? nB : cB + (t + 2) * kstep;
            const int a3 = a2 + kstep; const int b3 = b2 + kstep;
            if (last && has_next) S.a_ready(nxt);
            if constexpr (SP2) {
            PG8_LDB(B0, 0, 0); PG8_LDB(B1, 0, 1); PG8_SCHED; PG8_LDA(At, 0, 0); PG8_STAGE(PG8_SA(1, 1), a1 + hstep, voffA);
            PG8_WAIT_V(8); PG8_WAIT_L(0); PG8_BAR; PG8_MMA(0, 0, At, B0); PG8_MMA(0, 1, At, B1); PG8_BAR; PG8_SCHED;
            PG8_LDA(At, 0, 1); PG8_STAGE(PG8_SB(0, 0), b2, voffB); PG8_STAGE(PG8_SB(0, 1), b2 + hstep, voffB); PG8_STAGE(PG8_SA(0, 0), a2, voffA);
            PG8_WAIT_V(8); PG8_WAIT_L(0); PG8_BAR; PG8_MMA(1, 0, At, B0); PG8_MMA(1, 1, At, B1); PG8_BAR; PG8_SCHED;
            PG8_LDB(B0, 1, 0); PG8_LDB(B1, 1, 1); PG8_SCHED; PG8_LDA(At, 1, 0); PG8_STAGE(PG8_SA(0, 1), a2 + hstep, voffA);
            PG8_WAIT_V(8); PG8_WAIT_L(0); PG8_BAR; PG8_MMA(0, 0, At, B0); PG8_MMA(0, 1, At, B1); PG8_BAR; PG8_SCHED;
            PG8_LDA(At, 1, 1); PG8_STAGE(PG8_SB(1, 0), b3, voffB); PG8_STAGE(PG8_SB(1, 1), b3 + hstep, voffB); PG8_STAGE(PG8_SA(1, 0), a3, voffA);
            PG8_WAIT_V(8); PG8_WAIT_L(0); PG8_BAR; PG8_MMA(1, 0, At, B0); PG8_MMA(1, 1, At, B1); PG8_BAR; PG8_SCHED;
            } else {
            PG8_LDB(B0, 0, 0); PG8_SCHED; PG8_LDA(At, 0, 0); PG8_STAGE(PG8_SA(1, 1), a1 + hstep, voffA);
            PG8_WAIT_L(8); PG8_BAR; PG8_WAIT_L(0); PG8_MMA(0, 0, At, B0); PG8_BAR; PG8_SCHED;
            PG8_LDB(B1, 0, 1); PG8_STAGE(PG8_SB(0, 0), b2, voffB);
            PG8_BAR; PG8_WAIT_L(0); PG8_MMA(0, 1, At, B1); PG8_BAR;
            PG8_LDA(At, 0, 1); PG8_STAGE(PG8_SA(0, 0), a2, voffA);
            PG8_BAR; PG8_WAIT_L(0); PG8_MMA(1, 0, At, B0); PG8_BAR; PG8_SCHED;
            PG8_STAGE(PG8_SB(0, 1), b2 + hstep, voffB);
            PG8_WAIT_V(6); PG8_BAR; PG8_MMA(1, 1, At, B1); PG8_BAR;
            PG8_LDB(B0, 1, 0); PG8_SCHED; PG8_LDA(At, 1, 0); PG8_STAGE(PG8_SA(0, 1), a2 + hstep, voffA);
            PG8_WAIT_L(8); PG8_BAR; PG8_WAIT_L(0); PG8_MMA(0, 0, At, B0); PG8_BAR; PG8_SCHED;
            PG8_LDB(B1, 1, 1); PG8_STAGE(PG8_SB(1, 0), b3, voffB);
            PG8_BAR; PG8_WAIT_L(0); PG8_MMA(0, 1, At, B1); PG8_BAR;
            PG8_LDA(At, 1, 1); PG8_STAGE(PG8_SA(1, 0), a3, voffA);
            PG8_BAR; PG8_WAIT_L(0); PG8_MMA(1, 0, At, B0); PG8_BAR; PG8_SCHED;
            PG8_STAGE(PG8_SB(1, 1), b3 + hstep, voffB);
            PG8_WAIT_V(6); PG8_BAR; PG8_MMA(1, 1, At, B1); PG8_BAR;
            }
        }
        if constexpr (F8) asm volatile("s_nop 15\n\ts_nop 15" ::: "memory");
        if constexpr (ALIGN_EPI) { if (wr == 0) PG8_BAR; }
        if constexpr (!Epi::AFTER_DRAIN) { E(acc, cur, wr, wc, fr, fq);
#if EPI_DUP
            asm volatile("" ::: "memory"); E(acc, cur, wr, wc, fr, fq);
#endif
            S.done(cur); }
        if (!has_next) break;
#pragma unroll
        for (int a = 0; a < 2; ++a)
#pragma unroll
            for (int b = 0; b < 2; ++b)
#pragma unroll
                for (int m = 0; m < 4; ++m)
#pragma unroll
                    for (int n = 0; n < 2; ++n) acc[a][b][m][n] = (f32x4){0.f, 0.f, 0.f, 0.f};
        cur = nxt; cA = nA; cB = nB; ++ui;
        if constexpr (ALIGN_EPI) { if (wr == 1) PG8_BAR; }
    }
    PG8_WAIT_V(0);
    if constexpr (!ALIGN_EPI) { if (wr == 0) PG8_BAR; }
    PG8_BAR;
#undef PG8_SA
#undef PG8_SB
#undef PG8_STAGE
#undef PG8_RS_voffA
#undef PG8_RS_voffB
#undef PG8_LDA
#undef PG8_LDB
#undef PG8_MMA
#undef PG8_LD8
#undef PG8_WAIT_V
#undef PG8_WAIT_L
#undef PG8_BAR
#undef PG8_SCHED
}
}

#define XB_TMO      128
#define XB_XCNT(j)  (256  + 64 * (j))
#define XB_XSUB(j)  (1280 + 64 * (j))
#define XB_XGEN(j)  (2304 + 64 * (j))
#define XB_TOP      3328
#define XB_TOPGEN   3392
#define XCD_BAR_WORDS 3456
#define XB_SPIN_CAP (1u << 18)

__device__ __forceinline__ unsigned xb_ld(unsigned* p)              { return __hip_atomic_load(p, __ATOMIC_RELAXED, __HIP_MEMORY_SCOPE_AGENT); }
__device__ __forceinline__ unsigned xb_add(unsigned* p, unsigned v) { return __hip_atomic_fetch_add(p, v, __ATOMIC_RELAXED, __HIP_MEMORY_SCOPE_AGENT); }
__device__ __forceinline__ unsigned xb_xcc_id() { return (unsigned)__builtin_amdgcn_s_getreg((3 << 11) | 20) & 0xFu; }
#define XB_SPIN(cond, bar) do { unsigned _sp = 0; while (cond) { __builtin_amdgcn_s_sleep(1); \
    if ((++_sp & 255u) == 0u) { if (xb_ld(&(bar)[XB_TMO])) break; if (_sp > XB_SPIN_CAP) { atomicAdd(&(bar)[XB_TMO], 1u); break; } } } } while (0)

struct XcdBarrier {
    unsigned* bar; unsigned x;
    volatile LAS unsigned* st;
};
__device__ __forceinline__ XcdBarrier xcd_barrier_post(unsigned* bar, volatile LAS unsigned* st) {
    XcdBarrier b; b.bar = bar; b.x = xb_xcc_id(); b.st = st;
    if (threadIdx.x == 0) (void)xb_add(&bar[XB_XCNT(b.x)], 1u);
    return b;
}
__device__ __forceinline__ void xcd_barrier_complete(unsigned* bar, unsigned x, unsigned& nloc, unsigned& nx) {
    const unsigned G = gridDim.x * gridDim.y * gridDim.z;
    unsigned sum, cnt, mine, sp = 0u;
    for (;;) {
        sum = 0u; cnt = 0u; mine = 0u;
#pragma unroll
        for (unsigned j = 0; j < 16; ++j) { const unsigned c = xb_ld(&bar[XB_XCNT(j)]); sum += c; cnt += (c > 0u) ? 1u : 0u; mine = (j == x) ? c : mine; }
        if (sum == G) break;
        __builtin_amdgcn_s_sleep(1);
        if ((++sp & 255u) == 0u) { if (xb_ld(&bar[XB_TMO])) break; if (sp > XB_SPIN_CAP) { atomicAdd(&bar[XB_TMO], 1u); break; } }
    }
    nloc = mine > 0u ? mine : 1u; nx = cnt > 0u ? cnt : 1u;
}
__device__ __forceinline__ void xcd_barrier(const XcdBarrier& b) {
    asm volatile("s_waitcnt vmcnt(0)" ::: "memory");
    __syncthreads();
    if (threadIdx.x == 0) {
        unsigned* bar = b.bar;
        __builtin_amdgcn_s_waitcnt(0);
        unsigned nloc = b.st[0], nx = b.st[1];
        if (nloc == 0u) { xcd_barrier_complete(bar, b.x, nloc, nx); b.st[0] = nloc; b.st[1] = nx; }
        const unsigned old = xb_add(&bar[XB_XSUB(b.x)], 1u);
        const unsigned gen = old / nloc;
        if (old + 1u == (gen + 1u) * nloc) {
            __builtin_amdgcn_fence(__ATOMIC_RELEASE, "agent");
            asm volatile("s_waitcnt vmcnt(0)" ::: "memory");
            const unsigned og = xb_add(&bar[XB_TOP], 1u);
            const unsigned tg = og / nx;
            if (og + 1u == (tg + 1u) * nx) xb_add(&bar[XB_TOPGEN], 1u);
            else XB_SPIN(xb_ld(&bar[XB_TOPGEN]) == tg, bar);
            __builtin_amdgcn_fence(__ATOMIC_ACQUIRE, "agent");
            xb_add(&bar[XB_XGEN(b.x)], 1u);
            asm volatile("s_waitcnt vmcnt(0)" ::: "memory");
        } else {
            XB_SPIN(xb_ld(&bar[XB_XGEN(b.x)]) == gen, bar);
            __builtin_amdgcn_fence(__ATOMIC_ACQUIRE, "agent");
            asm volatile("s_waitcnt vmcnt(0)" ::: "memory");
        }
    }
    __syncthreads();
}

struct Frame {
    LAS unsigned char* lds;
    unsigned* ctl;
    int tid, lane, wave;
    int vcu, G;
};

__device__ __forceinline__ int dest_row(int c, int F) { if (F == 0) return c; const int bj = (c >= F) ? 1 : 0; const int cc = c - bj * F; return (cc >> 7) * 256 + bj * 128 + (cc & 127); }
__device__ __forceinline__ void cvt_item(const float* W, int K, int N, bf16_t* WT, int F, LAS float* scr, int item, int lane) {
    const int nblk = N >> 6, kb = item / nblk, nb = item - kb * nblk, k0 = 64 * kb, n0 = 64 * nb;
    const float* src = W + (size_t)(k0 + (lane >> 4)) * N + n0 + 4 * (lane & 15);
#pragma unroll 8
    for (int i = 0; i < 16; ++i) { const f32x4 v = *(const GAS f32x4*)(src + (size_t)(4 * i) * N);
        LAS float* d = scr + (4 * i + (lane >> 4)) * 65 + 4 * (lane & 15); d[0] = v.x; d[1] = v.y; d[2] = v.z; d[3] = v.w; }
    LDS_WAIT(); asm volatile("" ::: "memory");
    const int c = lane & 7;
#pragma unroll
    for (int j = 0; j < 8; ++j) { const int n = (lane >> 3) + 8 * j; const LAS float* s = scr + (8 * c) * 65 + n;
        u32x4 o; o.x = cvt_pk_bf16(s[0 * 65], s[1 * 65]); o.y = cvt_pk_bf16(s[2 * 65], s[3 * 65]); o.z = cvt_pk_bf16(s[4 * 65], s[5 * 65]); o.w = cvt_pk_bf16(s[6 * 65], s[7 * 65]);
        *(GAS u32x4*)(WT + (size_t)dest_row(n0 + n, F) * K + k0 + 8 * c) = o; }
    LDS_WAIT(); asm volatile("" ::: "memory");
}
__device__ __forceinline__ unsigned pk4_fp8(float a, float b, float c, float d, float sc) {
    int t = 0;
    t = __builtin_amdgcn_cvt_pk_fp8_f32(__builtin_amdgcn_fmed3f(a * sc, -448.f, 448.f), __builtin_amdgcn_fmed3f(b * sc, -448.f, 448.f), t, false);
    t = __builtin_amdgcn_cvt_pk_fp8_f32(__builtin_amdgcn_fmed3f(c * sc, -448.f, 448.f), __builtin_amdgcn_fmed3f(d * sc, -448.f, 448.f), t, true);
    return (unsigned)t;
}
__device__ __forceinline__ void cvt_item8(const float* W, int K, int N, unsigned char* WT, int F, float sc, LAS float* scr, int item, int lane) {
    const int nblk = N >> 6, kb = item / nblk, nb = item - kb * nblk, k0 = 64 * kb, n0 = 64 * nb;
    const float* src = W + (size_t)(k0 + (lane >> 4)) * N + n0 + 4 * (lane & 15);
#pragma unroll 8
    for (int i = 0; i < 16; ++i) { const f32x4 v = *(const GAS f32x4*)(src + (size_t)(4 * i) * N);
        LAS float* d = scr + (4 * i + (lane >> 4)) * 65 + 4 * (lane & 15); d[0] = v.x; d[1] = v.y; d[2] = v.z; d[3] = v.w; }
    LDS_WAIT(); asm volatile("" ::: "memory");
    const int c = lane & 3;
#pragma unroll
    for (int j = 0; j < 4; ++j) { const int n = (lane >> 2) + 16 * j; const LAS float* s = scr + (16 * c) * 65 + n;
        u32x4 o; o.x = pk4_fp8(s[0 * 65], s[1 * 65], s[2 * 65], s[3 * 65], sc); o.y = pk4_fp8(s[4 * 65], s[5 * 65], s[6 * 65], s[7 * 65], sc);
        o.z = pk4_fp8(s[8 * 65], s[9 * 65], s[10 * 65], s[11 * 65], sc); o.w = pk4_fp8(s[12 * 65], s[13 * 65], s[14 * 65], s[15 * 65], sc);
        *(GAS u32x4*)(WT + (size_t)dest_row(n0 + n, F) * K + k0 + 16 * c) = o; }
    LDS_WAIT(); asm volatile("" ::: "memory");
}
__device__ __forceinline__ void norm_rows(const Frame& F, const float* X, const float* gain, bf16_t* Hout) {
    const int gw = F.vcu * NWAVES + F.wave, NGW = F.G * NWAVES;
    f32x4 gv[8];
#pragma unroll
    for (int j = 0; j < 8; ++j) gv[j] = *((const GAS f32x4*)gain + F.lane + 64 * j);
    for (int row = gw; row < T; row += NGW) {
        const GAS f32x4* xr = (const GAS f32x4*)(X + (size_t)row * DM) + F.lane;
        f32x4 v[8]; float s = 0.f;
#pragma unroll
        for (int j = 0; j < 8; ++j) { v[j] = xr[64 * j]; s += (v[j].x * v[j].x + v[j].y * v[j].y) + (v[j].z * v[j].z + v[j].w * v[j].w); }
        const float rstd = 1.0f / sqrtf(wave_sum(s) * (1.0f / DM) + EPS);
        GAS u32x2* o8 = (GAS u32x2*)(Hout + (size_t)row * DM) + F.lane;
#pragma unroll
        for (int j = 0; j < 8; ++j) { u32x2 w; w.x = cvt_pk_bf16(v[j].x * rstd * gv[j].x, v[j].y * rstd * gv[j].y); w.y = cvt_pk_bf16(v[j].z * rstd * gv[j].z, v[j].w * rstd * gv[j].w); o8[64 * j] = w; }
    }
}
__device__ __forceinline__ void norm_rows8(const Frame& F, const float* X, const float* gain, unsigned char* Hout) {
    const int gw = F.vcu * NWAVES + F.wave, NGW = F.G * NWAVES;
    f32x4 gv[8];
#pragma unroll
    for (int j = 0; j < 8; ++j) gv[j] = *((const GAS f32x4*)gain + F.lane + 64 * j);
    for (int row = gw; row < T; row += NGW) {
        const GAS f32x4* xr = (const GAS f32x4*)(X + (size_t)row * DM) + F.lane;
        f32x4 v[8]; float s = 0.f;
#pragma unroll
        for (int j = 0; j < 8; ++j) { v[j] = xr[64 * j]; s += (v[j].x * v[j].x + v[j].y * v[j].y) + (v[j].z * v[j].z + v[j].w * v[j].w); }
        const float rstd = 1.0f / sqrtf(wave_sum(s) * (1.0f / DM) + EPS);
        GAS unsigned* o4 = (GAS unsigned*)(Hout + (size_t)row * DM) + F.lane;
#pragma unroll
        for (int j = 0; j < 8; ++j) { const f32x4 hn = v[j] * rstd * gv[j]; o4[64 * j] = pk4_fp8(hn.x, hn.y, hn.z, hn.w, H8_SCALE); }
    }
}
__device__ __forceinline__ void norm_rows_i8(const Frame& F, const float* X, const float* gain, unsigned char* Hout) {
    const int gw = F.vcu * NWAVES + F.wave, NGW = F.G * NWAVES;
    f32x4 gv[8];
#pragma unroll
    for (int j = 0; j < 8; ++j) gv[j] = *((const GAS f32x4*)gain + F.lane + 64 * j);
    for (int row = gw; row < T; row += NGW) {
        const GAS f32x4* xr = (const GAS f32x4*)(X + (size_t)row * DM) + F.lane;
        f32x4 v[8]; float s = 0.f;
#pragma unroll
        for (int j = 0; j < 8; ++j) { v[j] = xr[64 * j]; s += (v[j].x * v[j].x + v[j].y * v[j].y) + (v[j].z * v[j].z + v[j].w * v[j].w); }
        const float rstd = 1.0f / sqrtf(wave_sum(s) * (1.0f / DM) + EPS);
        GAS unsigned* o4 = (GAS unsigned*)(Hout + (size_t)row * DM) + F.lane;
#pragma unroll
        for (int j = 0; j < 8; ++j) { const f32x4 hn = v[j] * rstd * gv[j]; o4[64 * j] = pk4_i8(hn.x, hn.y, hn.z, hn.w, HI8_SCALE); }
    }
}
__device__ __forceinline__ void norm_rows_i8b(const Frame& F, const bf16_t* X, const float* gain, unsigned char* Hout) {
    const int gw = F.vcu * NWAVES + F.wave, NGW = F.G * NWAVES;
    f32x4 gv[8];
#pragma unroll
    for (int j = 0; j < 8; ++j) gv[j] = *((const GAS f32x4*)gain + F.lane + 64 * j);
    for (int row = gw; row < T; row += NGW) {
        const GAS u32x2* xr = (const GAS u32x2*)(X + (size_t)row * DM) + F.lane;
        f32x4 v[8]; float s = 0.f;
#pragma unroll
        for (int j = 0; j < 8; ++j) { const u32x2 a = xr[64 * j]; v[j] = (f32x4){bf_lo(a.x), bf_hi(a.x), bf_lo(a.y), bf_hi(a.y)}; s += (v[j].x * v[j].x + v[j].y * v[j].y) + (v[j].z * v[j].z + v[j].w * v[j].w); }
        const float rstd = 1.0f / sqrtf(wave_sum(s) * (1.0f / DM) + EPS);
        GAS unsigned* o4 = (GAS unsigned*)(Hout + (size_t)row * DM) + F.lane;
#pragma unroll
        for (int j = 0; j < 8; ++j) { const f32x4 hn = v[j] * rstd * gv[j]; o4[64 * j] = pk4_i8(hn.x, hn.y, hn.z, hn.w, HI8_SCALE); }
    }
}
__device__ __forceinline__ void norm_rows_f32(const Frame& F, const float* X, const float* gain, float* out) {
    const int gw = F.vcu * NWAVES + F.wave, NGW = F.G * NWAVES;
    for (int row = gw; row < T; row += NGW) {
        const GAS f32x4* xr = (const GAS f32x4*)(X + (size_t)row * DM) + F.lane;
        f32x4 v[8]; float s = 0.f;
#pragma unroll
        for (int j = 0; j < 8; ++j) { v[j] = xr[64 * j]; s += (v[j].x * v[j].x + v[j].y * v[j].y) + (v[j].z * v[j].z + v[j].w * v[j].w); }
        const float rstd = 1.0f / sqrtf(wave_sum(s) * (1.0f / DM) + EPS);
        GAS f32x4* o = (GAS f32x4*)(out + (size_t)row * DM) + F.lane;
#pragma unroll
        for (int j = 0; j < 8; ++j) { const f32x4 gvv = *((const GAS f32x4*)gain + F.lane + 64 * j); o[64 * j] = v[j] * rstd * gvv; }
    }
}

struct Ptrs {
    const float *x, *ln_mix, *ln_ffn, *ln_final, *ret_w_in, *ret_w_out, *ffn_w_in, *ffn_w_out, *att_w_in, *att_w_out, *rel_bias, *router, *moe_w_in, *moe_w_out;
    float* out;
    bf16_t *W_RIN, *W_ROUT, *W_FIN, *W_FOUT, *W_AIN, *W_AOUT;
    unsigned char *W_MIN, *W_MOUT, *H8, *ACT2, *AG, *AO8, *AGC;
    bf16_t *H, *PROJ, *ACT, *QKV, *OB, *AO, *Y;
    bf16_t *X1, *X2, *X3; float* SSP; bf16_t* YB;
    int* LIST; unsigned* TOK;
};

constexpr int I_RIN = (DM / 64) * (NRET / 64), I_ROUT = (RHV / 64) * (DM / 64), I_FIN = (DM / 64) * (2 * FF / 64), I_FOUT = (FF / 64) * (DM / 64);
constexpr int I_AIN = (DM / 64) * (NATT / 64), I_AOUT = (DM / 64) * (DM / 64), I_MIN1 = (DM / 64) * (2 * FE / 64), I_MOUT1 = (FE / 64) * (DM / 64);
constexpr int NI_DENSE = I_RIN + I_ROUT + I_FIN + I_FOUT + I_AIN + I_AOUT, NITEMS = NI_DENSE + NE * I_MIN1 + NE * I_MOUT1;
constexpr int NI_SPLIT = I_RIN + I_ROUT;
struct P0Item { const float* src; unsigned char* dst; int N, K, F, k0, n0, fp8; float sc; };
__device__ __forceinline__ P0Item p0_decode(const Ptrs& P, int it) {
    P0Item d; int r = it;
    if (r < I_RIN) { d.src = P.ret_w_in; d.dst = (unsigned char*)P.W_RIN; d.N = NRET; d.K = DM; d.F = 0; d.fp8 = I8_RIN ? 2 : 0; d.sc = I8_RIN ? WI8_SCALE : 1.f; }
    else if ((r -= I_RIN) < I_ROUT) { d.src = P.ret_w_out; d.dst = (unsigned char*)P.W_ROUT; d.N = DM; d.K = RHV; d.F = 0; d.fp8 = 0; d.sc = 1.f; }
    else if ((r -= I_ROUT) < I_FIN) { d.src = P.ffn_w_in; d.dst = (unsigned char*)P.W_FIN; d.N = 2 * FF; d.K = DM; d.F = FF; d.fp8 = 2; d.sc = WI8_SCALE; }
    else if ((r -= I_FIN) < I_FOUT) { d.src = P.ffn_w_out; d.dst = (unsigned char*)P.W_FOUT; d.N = DM; d.K = FF; d.F = 0; d.fp8 = F8_FOUT ? 1 : 0; d.sc = F8_FOUT ? W2_SCALE : 1.f; }
    else if ((r -= I_FOUT) < I_AIN) { d.src = P.att_w_in; d.dst = (unsigned char*)P.W_AIN; d.N = NATT; d.K = DM; d.F = 0; d.fp8 = I8_QKV ? 2 : 1; d.sc = I8_QKV ? WI8_SCALE : W1_SCALE; }
    else if ((r -= I_AIN) < I_AOUT) { d.src = P.att_w_out; d.dst = (unsigned char*)P.W_AOUT; d.N = DM; d.K = DM; d.F = 0; d.fp8 = 1; d.sc = W1_SCALE; }
    else if ((r -= I_AOUT) < NE * I_MIN1) { const int e = r / I_MIN1; r -= e * I_MIN1; d.src = P.moe_w_in + (size_t)e * DM * 2 * FE; d.dst = P.W_MIN + (size_t)e * 2 * FE * DM; d.N = 2 * FE; d.K = DM; d.F = FE; d.fp8 = I8_MOE ? 2 : 1; d.sc = I8_MOE ? WI8_SCALE : W1_SCALE; }
    else { r -= NE * I_MIN1; const int e = r / I_MOUT1; r -= e * I_MOUT1; d.src = P.moe_w_out + (size_t)e * FE * DM; d.dst = P.W_MOUT + (size_t)e * DM * FE; d.N = DM; d.K = FE; d.F = 0; d.fp8 = 1; d.sc = W2_SCALE; }
    const int nblk = d.N >> 6, kb = r / nblk, nb = r - kb * nblk; d.k0 = 64 * kb; d.n0 = 64 * nb;
    return d;
}
#define P0_LOAD(D, R) do { const float* s_ = (D).src + (size_t)((D).k0 + (lane >> 4)) * (D).N + (D).n0 + 4 * (lane & 15); \
        _Pragma("unroll") for (int i = 0; i < 16; ++i) R[i] = *(const GAS f32x4*)(s_ + (size_t)(4 * i) * (D).N); } while (0)
__device__ __forceinline__ void p0_process(const P0Item& d, const f32x4 (&v)[16], LAS float* scr, int lane) {
#pragma unroll
    for (int i = 0; i < 16; ++i) { LAS float* q = scr + (4 * i + (lane >> 4)) * 65 + 4 * (lane & 15); q[0] = v[i].x; q[1] = v[i].y; q[2] = v[i].z; q[3] = v[i].w; }
    LDS_WAIT(); asm volatile("" ::: "memory");
    if (d.fp8) { const int c = lane & 3;
#pragma unroll
        for (int j = 0; j < 4; ++j) { const int n = (lane >> 2) + 16 * j; const LAS float* s = scr + (16 * c) * 65 + n;
            u32x4 o;
            if (d.fp8 == 2) { o.x = pk4_i8(s[0 * 65], s[1 * 65], s[2 * 65], s[3 * 65], d.sc); o.y = pk4_i8(s[4 * 65], s[5 * 65], s[6 * 65], s[7 * 65], d.sc);
                o.z = pk4_i8(s[8 * 65], s[9 * 65], s[10 * 65], s[11 * 65], d.sc); o.w = pk4_i8(s[12 * 65], s[13 * 65], s[14 * 65], s[15 * 65], d.sc); }
            else { o.x = pk4_fp8(s[0 * 65], s[1 * 65], s[2 * 65], s[3 * 65], d.sc); o.y = pk4_fp8(s[4 * 65], s[5 * 65], s[6 * 65], s[7 * 65], d.sc);
                o.z = pk4_fp8(s[8 * 65], s[9 * 65], s[10 * 65], s[11 * 65], d.sc); o.w = pk4_fp8(s[12 * 65], s[13 * 65], s[14 * 65], s[15 * 65], d.sc); }
            *(GAS u32x4*)(d.dst + (size_t)dest_row(d.n0 + n, d.F) * d.K + d.k0 + 16 * c) = o; }
    } else { const int c = lane & 7;
#pragma unroll
        for (int j = 0; j < 8; ++j) { const int n = (lane >> 3) + 8 * j; const LAS float* s = scr + (8 * c) * 65 + n;
            u32x4 o; o.x = cvt_pk_bf16(s[0 * 65], s[1 * 65]); o.y = cvt_pk_bf16(s[2 * 65], s[3 * 65]); o.z = cvt_pk_bf16(s[4 * 65], s[5 * 65]); o.w = cvt_pk_bf16(s[6 * 65], s[7 * 65]);
            *(GAS u32x4*)((bf16_t*)d.dst + (size_t)dest_row(d.n0 + n, d.F) * d.K + d.k0 + 8 * c) = o; }
    }
    LDS_WAIT(); asm volatile("" ::: "memory");
}
__device__ __forceinline__ void cvt_items(const Frame& F, const Ptrs& P, int lo, int hi, int w, int nw) {
    LAS float* scr = (LAS float*)(F.lds + F.wave * 16640);
    const int lane = F.lane;
    f32x4 ra[16], rb[16];
    int it = lo + w;
    if (it < hi) { P0Item da = p0_decode(P, it); P0_LOAD(da, ra);
        for (;;) {
            const int i1 = it + nw; P0Item db = da; if (i1 < hi) { db = p0_decode(P, i1); P0_LOAD(db, rb); }
            p0_process(da, ra, scr, lane);
            if (i1 >= hi) break;
            const int i2 = i1 + nw; if (i2 < hi) { da = p0_decode(P, i2); P0_LOAD(da, ra); }
            p0_process(db, rb, scr, lane);
            if (i2 >= hi) break;
            it = i2;
        }
    }
}

constexpr int CI_FIN = (DM / 128) * (2 * FF / 256), CI_FOUT = (FF / 128) * (DM / 256), CI_AIN = (DM / 128) * (NATT / 256), CI_AOUT = (DM / 128) * (DM / 256);
constexpr int CI_MIN1 = (DM / 128) * (2 * FE / 256), CI_MOUT1 = (FE / 128) * (DM / 256), NCI = CI_FIN + CI_FOUT + CI_AIN + CI_AOUT + NE * CI_MIN1 + NE * CI_MOUT1;
__device__ __forceinline__ P0Item c_decode(const Ptrs& P, int it) {
    P0Item d; int r = it;
    if (r < CI_FIN) { d.src = P.ffn_w_in; d.dst = (unsigned char*)P.W_FIN; d.N = 2 * FF; d.K = DM; d.F = FF; d.fp8 = 2; d.sc = WI8_SCALE; }
    else if ((r -= CI_FIN) < CI_FOUT) { d.src = P.ffn_w_out; d.dst = (unsigned char*)P.W_FOUT; d.N = DM; d.K = FF; d.F = 0; d.fp8 = 1; d.sc = W2_SCALE; }
    else if ((r -= CI_FOUT) < CI_AIN) { d.src = P.att_w_in; d.dst = (unsigned char*)P.W_AIN; d.N = NATT; d.K = DM; d.F = 0; d.fp8 = I8_QKV ? 2 : 1; d.sc = I8_QKV ? WI8_SCALE : W1_SCALE; }
    else if ((r -= CI_AIN) < CI_AOUT) { d.src = P.att_w_out; d.dst = (unsigned char*)P.W_AOUT; d.N = DM; d.K = DM; d.F = 0; d.fp8 = 1; d.sc = W1_SCALE; }
    else if ((r -= CI_AOUT) < NE * CI_MIN1) { const int e = r / CI_MIN1; r -= e * CI_MIN1; d.src = P.moe_w_in + (size_t)e * DM * 2 * FE; d.dst = P.W_MIN + (size_t)e * 2 * FE * DM; d.N = 2 * FE; d.K = DM; d.F = FE; d.fp8 = I8_MOE ? 2 : 1; d.sc = I8_MOE ? WI8_SCALE : W1_SCALE; }
    else { r -= NE * CI_MIN1; const int e = r / CI_MOUT1; r -= e * CI_MOUT1; d.src = P.moe_w_out + (size_t)e * FE * DM; d.dst = P.W_MOUT + (size_t)e * DM * FE; d.N = DM; d.K = FE; d.F = 0; d.fp8 = 1; d.sc = W2_SCALE; }
    const int nblk = d.N >> 8, kb = r / nblk, nb = r - kb * nblk; d.k0 = 128 * kb; d.n0 = 256 * nb;
    return d;
}
#define C_LOAD(D, R) do { const float* s_ = (D).src + (size_t)((D).k0 + 16 * wave) * (D).N + (D).n0 + 4 * lane; \
        _Pragma("unroll") for (int i = 0; i < 16; ++i) R[i] = *(const GAS f32x4*)(s_ + (size_t)i * (D).N); } while (0)
__device__ __forceinline__ void c_process(const P0Item& d, const f32x4 (&v)[16], LAS unsigned char* Tl, int wave, int lane) {
#pragma unroll
    for (int j = 0; j < 4; ++j) { u32x4 o;
        if (d.fp8 == 2) { o.x = pk4_i8(v[0][j], v[1][j], v[2][j], v[3][j], d.sc); o.y = pk4_i8(v[4][j], v[5][j], v[6][j], v[7][j], d.sc);
            o.z = pk4_i8(v[8][j], v[9][j], v[10][j], v[11][j], d.sc); o.w = pk4_i8(v[12][j], v[13][j], v[14][j], v[15][j], d.sc); }
        else { o.x = pk4_fp8(v[0][j], v[1][j], v[2][j], v[3][j], d.sc); o.y = pk4_fp8(v[4][j], v[5][j], v[6][j], v[7][j], d.sc);
            o.z = pk4_fp8(v[8][j], v[9][j], v[10][j], v[11][j], d.sc); o.w = pk4_fp8(v[12][j], v[13][j], v[14][j], v[15][j], d.sc); }
        *(LAS u32x4*)(Tl + (4 * lane + j) * 128 + ((wave ^ (lane & 7)) << 4)) = o; }
    __syncthreads();
#pragma unroll
    for (int q = 0; q < 4; ++q) { const int n = 32 * wave + 8 * q + (lane >> 3), c = lane & 7;
        const u32x4 o = *(const LAS u32x4*)(Tl + n * 128 + ((c ^ ((n >> 2) & 7)) << 4));
        *(GAS u32x4*)(d.dst + (size_t)dest_row(d.n0 + n, d.F) * d.K + d.k0 + 16 * c) = o; }
}
__device__ __forceinline__ void cvt_coop(const Frame& F, const Ptrs& P, int cw, int ncw) {
    const int lane = F.lane, wave = F.wave;
    f32x4 ra[16], rb[16];
    int it = cw, buf = 0;
    if (it >= NCI) return;
    P0Item da = c_decode(P, it); C_LOAD(da, ra);
    for (;;) {
        const int i1 = it + ncw; const bool h1 = i1 < NCI; P0Item db = da; if (h1) { db = c_decode(P, i1); C_LOAD(db, rb); }
        c_process(da, ra, F.lds + buf * 32768, wave, lane); buf ^= 1;
        if (!h1) break;
        const int i2 = i1 + ncw; const bool h2 = i2 < NCI; if (h2) { da = c_decode(P, i2); C_LOAD(da, ra); }
        c_process(db, rb, F.lds + buf * 32768, wave, lane); buf ^= 1;
        if (!h2) break;
        it = i2;
    }
}
__device__ __forceinline__ void p0_prologue(const Frame& F, const Ptrs& P) {
    cvt_items(F, P, 0, (F.G == 256) ? NI_SPLIT : NITEMS, F.vcu * NWAVES + F.wave, F.G * NWAVES);
    if (I8_RIN) norm_rows_i8(F, P.x, P.ln_mix, P.H8); else norm_rows(F, P.x, P.ln_mix, P.H);
}

__device__ __forceinline__ float row16_sum(float v) {
    v += __builtin_bit_cast(float, __builtin_amdgcn_update_dpp(0, __builtin_bit_cast(int, v), 0xB1, 0xf, 0xf, true));
    v += __builtin_bit_cast(float, __builtin_amdgcn_update_dpp(0, __builtin_bit_cast(int, v), 0x4E, 0xf, 0xf, true));
    v += __builtin_bit_cast(float, __builtin_amdgcn_update_dpp(0, __builtin_bit_cast(int, v), 0x141, 0xf, 0xf, true));
    v += __builtin_bit_cast(float, __builtin_amdgcn_update_dpp(0, __builtin_bit_cast(int, v), 0x140, 0xf, 0xf, true));
    return v;
}
__device__ __forceinline__ s16x4 lds_tr(LAS unsigned char* p) { return __builtin_amdgcn_ds_read_tr16_b64_v4i16((LAS s16x4*)p); }
__device__ __forceinline__ f32x4 mfma16(bf16x8 a, bf16x8 b, f32x4 c) { return __builtin_amdgcn_mfma_f32_16x16x32_bf16(a, b, c, 0, 0, 0); }
#define CAT8(lo, hi) ((bf16x8){(lo)[0], (lo)[1], (lo)[2], (lo)[3], (hi)[0], (hi)[1], (hi)[2], (hi)[3]})

__device__ __forceinline__ void retention_phase(const Frame& F, const Ptrs& P) {
    constexpr int QS = 0, KS = 33792, VS = 67584, SSO = 84992, SSW = 94208;
    constexpr int QST = 528, VST = 272, SST = 144;
    LAS unsigned char* L = F.lds;
    const int tid = F.tid, lane = F.lane, w = F.wave, c16 = lane & 15, g = lane >> 4, q4 = c16 >> 2, p4 = c16 & 3;
    const bool split = (F.G == 256);
    const int bx = (int)blockIdx.x, ridx = (bx >> 3) * 4 + ((bx & 7) >> 1);
    if (split && (bx & 1)) { cvt_coop(F, P, ridx, 128); return; }
    const int u0 = split ? (((bx >> 5) << 4) + (((bx & 7) >> 1) << 2) + ((bx >> 3) & 3)) : bx, ustep = split ? 128 : F.G;
    for (int unit = u0; unit < NBATCH * RH * 4; unit += ustep) {
        const int b = unit >> 5, h = (unit >> 2) & 7, vs = unit & 3;
        const float xg = __builtin_amdgcn_exp2f(-(float)(5 + h));
        const float l2g = -(xg * (1.f + xg * (0.5f + xg * (1.f / 3.f + xg * (0.25f + xg * (0.2f + xg * (1.f / 6.f))))))) * LOG2E;
        const float cdec = __builtin_amdgcn_exp2f(l2g * 64.f);
        f32x4 st[16];
#pragma unroll
        for (int i = 0; i < 16; ++i) st[i] = (f32x4){0.f, 0.f, 0.f, 0.f};
        u32x4 rq[4], rk[4], rv[2];
        const unsigned lqk = (unsigned)((tid >> 5) * NRET + (tid & 31) * 8), lvv = (unsigned)((tid >> 4) * NRET + (tid & 15) * 8);
#define RET_LOAD(cc) do { const bf16_t* pb = P.PROJ + ((size_t)b * SEQ + (size_t)(cc) * CHUNK) * NRET; \
            _Pragma("unroll") for (int i = 0; i < 4; ++i) { const bf16_t* src = pb + (size_t)(16 * i) * NRET + h * RDK; \
                rq[i] = *(const GAS u32x4*)(src + lqk); rk[i] = *(const GAS u32x4*)(src + DM + lqk); } \
            _Pragma("unroll") for (int i = 0; i < 2; ++i) { const bf16_t* src = pb + (size_t)(32 * i) * NRET + 2 * DM + h * RDV + vs * 128; \
                rv[i] = *(const GAS u32x4*)(src + lvv); } } while (0)
        RET_LOAD(0);
        for (int c = 0; c < SEQ / CHUNK; ++c) {
            const size_t t0 = (size_t)b * SEQ + (size_t)c * CHUNK;
            __syncthreads();
            if (c > 0 && tid < 64) { float s = 0.f;
#pragma unroll
                for (int ww = 0; ww < 8; ++ww) s += *(LAS float*)(L + SSW + (ww * 64 + tid) * 4);
                P.SSP[(t0 - CHUNK + tid) * 32 + h * 4 + vs] = s; }
#pragma unroll
            for (int i = 0; i < 4; ++i) { const int ci = tid + 512 * i, row = ci >> 5, ch = ci & 31;
                *(LAS u32x4*)(L + QS + row * QST + ch * 16) = rq[i]; *(LAS u32x4*)(L + KS + row * QST + ch * 16) = rk[i]; }
#pragma unroll
            for (int i = 0; i < 2; ++i) { const int ci = tid + 512 * i, row = ci >> 4, ch = ci & 15; *(LAS u32x4*)(L + VS + row * VST + ch * 16) = rv[i]; }
            __syncthreads();
            if (c + 1 < SEQ / CHUNK) RET_LOAD(c + 1);
            float lg = l2g; int gq = 4 * g, cq = c16;
            asm volatile("" : "+v"(lg), "+v"(gq), "+v"(cq));
            {
                const int nt = w >> 1;
                f32x4 a4[2] = {(f32x4){0.f, 0.f, 0.f, 0.f}, (f32x4){0.f, 0.f, 0.f, 0.f}};
#pragma unroll
                for (int s = 0; s < 8; ++s) { const bf16x8 qb = *(const LAS bf16x8*)(L + QS + (16 * nt + c16) * QST + (32 * s + 8 * g) * 2);
#pragma unroll
                    for (int mi = 0; mi < 2; ++mi) { const int mt = 2 * (w & 1) + mi;
                        const bf16x8 ka = *(const LAS bf16x8*)(L + KS + (16 * mt + c16) * QST + (32 * s + 8 * g) * 2);
                        a4[mi] = mfma16(ka, qb, a4[mi]); } }
                const int n = 16 * nt + c16;
#pragma unroll
                for (int mi = 0; mi < 2; ++mi) { const int mt = 2 * (w & 1) + mi; const int nm = 16 * (nt - mt) + cq - gq;
#pragma unroll
                    for (int r = 0; r < 4; ++r) { const int d0 = nm - r; const int dd = d0 < 0 ? -d0 : d0; a4[mi][r] *= __builtin_amdgcn_exp2f(lg * (float)dd); }
                    u32x2 pk; pk.x = cvt_pk_bf16(a4[mi][0], a4[mi][1]); pk.y = cvt_pk_bf16(a4[mi][2], a4[mi][3]);
                    *(LAS u32x2*)(L + SSO + n * SST + (16 * mt + 4 * g) * 2) = pk; }
            }
            __syncthreads();
            f32x4 ac[4];
#pragma unroll
            for (int nt = 0; nt < 4; ++nt) ac[nt] = (f32x4){0.f, 0.f, 0.f, 0.f};
#pragma unroll
            for (int s = 0; s < 8; ++s) { u32x4 pw; pw.x = cvt_pk_bf16(st[2 * s][0], st[2 * s][1]); pw.y = cvt_pk_bf16(st[2 * s][2], st[2 * s][3]);
                pw.z = cvt_pk_bf16(st[2 * s + 1][0], st[2 * s + 1][1]); pw.w = cvt_pk_bf16(st[2 * s + 1][2], st[2 * s + 1][3]); const bf16x8 sbs = __builtin_bit_cast(bf16x8, pw);
#pragma unroll
                for (int nt = 0; nt < 4; ++nt) { const s16x4 lo = *(const LAS s16x4*)(L + QS + (16 * nt + c16) * QST + (32 * s + 4 * g) * 2);
                    const s16x4 hi = *(const LAS s16x4*)(L + QS + (16 * nt + c16) * QST + (32 * s + 16 + 4 * g) * 2);
                    ac[nt] = mfma16(CAT8(lo, hi), sbs, ac[nt]); }
                if (s & 1) __builtin_amdgcn_sched_barrier(0); }
#pragma unroll
            for (int nt = 0; nt < 4; ++nt)
#pragma unroll
                for (int r = 0; r < 4; ++r) ac[nt][r] *= __builtin_amdgcn_exp2f(fmaf(lg, (float)(16 * nt + r + 1), lg * (float)gq));
            bf16x8 vf[2];
#pragma unroll
            for (int s = 0; s < 2; ++s) { const s16x4 lo = lds_tr(L + VS + (32 * s + 8 * g + q4) * VST + (16 * w + 4 * p4) * 2);
                const s16x4 hi = lds_tr(L + VS + (32 * s + 8 * g + 4 + q4) * VST + (16 * w + 4 * p4) * 2);
                vf[s] = CAT8(lo, hi); }
#pragma unroll
            for (int s = 0; s < 2; ++s)
#pragma unroll
                for (int nt = 0; nt < 4; ++nt) { const bf16x8 sa = *(const LAS bf16x8*)(L + SSO + (16 * nt + c16) * SST + (32 * s + 8 * g) * 2); ac[nt] = mfma16(sa, vf[s], ac[nt]); }
            f32x4 sqv[4];
            const unsigned obo = (unsigned)(4 * g * RHV + c16);
#pragma unroll
            for (int nt = 0; nt < 4; ++nt) {
#pragma unroll
                for (int r = 0; r < 4; ++r) { const float o = ac[nt][r];
                    ((GAS bf16_t*)(P.OB + (t0 + 16 * nt + r) * RHV + h * RDV + vs * 128 + 16 * w))[obo] = (bf16_t)(cvt_pk_bf16(o, 0.f) & 0xffffu);
                    sqv[nt][r] = row16_sum(o * o); } }
            if (c16 == 0) {
#pragma unroll
                for (int nt = 0; nt < 4; ++nt) *(LAS f32x4*)(L + SSW + (w * 64 + 16 * nt + 4 * g) * 4) = sqv[nt]; }
            __builtin_amdgcn_sched_barrier(0);
            bf16x8 vd[2];
#pragma unroll
            for (int s = 0; s < 2; ++s) { float fv[8];
#pragma unroll
                for (int j = 0; j < 8; ++j) fv[j] = __uint_as_float(((unsigned)(unsigned short)vf[s][j]) << 16) * __builtin_amdgcn_exp2f(fmaf(lg, (float)(63 - 32 * s - j), -2.0f * lg * (float)gq));
                u32x4 pw; pw.x = cvt_pk_bf16(fv[0], fv[1]); pw.y = cvt_pk_bf16(fv[2], fv[3]); pw.z = cvt_pk_bf16(fv[4], fv[5]); pw.w = cvt_pk_bf16(fv[6], fv[7]);
                vd[s] = __builtin_bit_cast(bf16x8, pw); }
#pragma unroll
            for (int dt = 0; dt < 16; ++dt) { st[dt] = st[dt] * cdec;
#pragma unroll
                for (int s = 0; s < 2; ++s) { const s16x4 lo = lds_tr(L + KS + (32 * s + 8 * g + q4) * QST + (16 * dt + 4 * p4) * 2);
                    const s16x4 hi = lds_tr(L + KS + (32 * s + 8 * g + 4 + q4) * QST + (16 * dt + 4 * p4) * 2);
                    st[dt] = mfma16(CAT8(lo, hi), vd[s], st[dt]); }
                if (dt & 1) __builtin_amdgcn_sched_barrier(0); }
        }
#undef RET_LOAD
        __syncthreads();
        if (tid < 64) { float s = 0.f;
#pragma unroll
            for (int ww = 0; ww < 8; ++ww) s += *(LAS float*)(L + SSW + (ww * 64 + tid) * 4);
            P.SSP[((size_t)b * SEQ + SEQ - CHUNK + tid) * 32 + h * 4 + vs] = s; }
    }
}
__device__ __forceinline__ void gate_phase(const Frame& F, const Ptrs& P) {
    const int gw = F.vcu * NWAVES + F.wave, NGW = F.G * NWAVES;
    for (int row = gw; row < T; row += NGW) {
#pragma unroll
        for (int j = 0; j < 8; ++j) {
            const int idx = F.lane + 64 * j;
            const u32x4 ov = *((const GAS u32x4*)(P.OB + (size_t)row * RHV) + idx);
            const u32x4 gv = *((const GAS u32x4*)(P.PROJ + (size_t)row * NRET + 2 * DM + RHV) + idx);
            const f32x4 ss = *(const GAS f32x4*)(P.SSP + (size_t)row * 32 + 4 * j);
            const float rstd = 1.0f / sqrtf(((ss.x + ss.y) + (ss.z + ss.w)) * (1.0f / RDV) + EPS);
            u32x4 yo;
#define GATE1(W) cvt_pk_bf16(silu_f(bf_lo(gv.W)) * bf_lo(ov.W) * rstd, silu_f(bf_hi(gv.W)) * bf_hi(ov.W) * rstd)
            yo.x = GATE1(x); yo.y = GATE1(y); yo.z = GATE1(z); yo.w = GATE1(w);
#undef GATE1
            *((GAS u32x4*)(P.Y + (size_t)row * RHV) + idx) = yo;
        }
    }
}

__device__ __forceinline__ int crow(int r, int hi) { return (r & 3) + 8 * (r >> 2) + 4 * hi; }
#define KSWZ(row, colB) ((row) * 256 + ((colB) ^ (((row) & 7) << 4)))
__device__ __forceinline__ int v_st(int k, int c) { const int kk = (k & ~0xC) | ((k & 4) << 1) | ((k & 8) >> 1); return ((kk >> 3) * 4 + (c >> 5)) * 512 + ((kk & 7) * 32 + (c & 31)) * 2; }
__device__ __forceinline__ int v_rd_base(int lane) { return ((lane & 3) << 3) | (((lane >> 2) & 3) << 6) | (((lane >> 4) & 1) << 5) | (((lane >> 5) & 1) << 8); }
__device__ __forceinline__ f32x16 mfma32(bf16x8 a, bf16x8 b, f32x16 c) { return __builtin_amdgcn_mfma_f32_32x32x16_bf16(a, b, c, 0, 0, 0); }

__device__ __forceinline__ void attention_phase(const Frame& F, const Ptrs& P) {
    constexpr int VL = 0, KL = 32768, WSL = 65536, BL = 67584;
    constexpr float C = 0.08838834764831845f * LOG2E;
    LAS unsigned char* L = F.lds;
    const int tid = F.tid, lane = F.lane, w = F.wave, r32 = lane & 31, hi = lane >> 5;
    LAS float* al_l = (LAS float*)(L + WSL + w * 256); LAS float* li_l = al_l + 32;
    const int sr = tid >> 4, sc = (tid & 15) * 8, vst0 = v_st(sr, sc), vst1 = v_st(32 + sr, sc);
    const int vb = VL + v_rd_base(lane);
    for (int uj = blockIdx.x; uj < NBATCH * AH * 8 * ((DUP_MASK & 0x400) ? 2 : 1); uj += F.G) {
        const int ui = uj & (NBATCH * AH * 8 - 1);
        const int qb = ui >> 7, bh = ui & 127, b = bh >> 4, h = bh & 15;
        __syncthreads();
        if (tid < 257) *(LAS float*)(L + BL + tid * 4) = P.rel_bias[h * 257 + tid] * LOG2E;
        const size_t tq0 = (size_t)b * SEQ + (size_t)qb * 256;
        bf16x8 qr[8];
        { const bf16_t* Qw = P.QKV + (tq0 + 32 * w + r32) * NATT + h * AD + hi * 8;
#pragma unroll
          for (int d0 = 0; d0 < 8; ++d0) qr[d0] = *(const GAS bf16x8*)(Qw + d0 * 16); }
        const int kt_lo = (4 * qb - 8) > 0 ? (4 * qb - 8) : 0, kt_hi = 4 * qb + 3, cw = 4 * qb + (w >> 1), qrow = (w & 1) * 32 + r32;
        float m_reg = -1e30f, l_reg = 0.f; f32x16 o[4];
#pragma unroll
        for (int d = 0; d < 4; ++d)
#pragma unroll
            for (int r = 0; r < 16; ++r) o[d][r] = 0.f;
        u32x4 sk0, sk1, sv0, sv1;
#define ASLOAD(kt) do { const bf16_t* kp = P.QKV + ((size_t)b * SEQ + (size_t)(kt) * 64 + sr) * NATT + DM + h * AD + sc; \
        sk0 = *(const GAS u32x4*)(kp); sk1 = *(const GAS u32x4*)(kp + (size_t)32 * NATT); sv0 = *(const GAS u32x4*)(kp + DM); sv1 = *(const GAS u32x4*)(kp + (size_t)32 * NATT + DM); } while (0)
        ASLOAD(kt_lo);
        for (int kt = kt_lo; kt <= kt_hi; ++kt) {
            const int bo = (kt & 1) * 16384;
            *(LAS u32x4*)(L + VL + bo + vst0) = sv0; *(LAS u32x4*)(L + VL + bo + vst1) = sv1;
            *(LAS u32x4*)(L + KL + bo + KSWZ(sr, sc * 2)) = sk0; *(LAS u32x4*)(L + KL + bo + KSWZ(32 + sr, sc * 2)) = sk1;
            __syncthreads();
            if (kt < kt_hi) ASLOAD(kt + 1);
            const int delta = cw - kt;
            if (delta >= 0 && delta <= 8) {
                f32x16 p0, p1;
#pragma unroll
                for (int r = 0; r < 16; ++r) { p0[r] = 0.f; p1[r] = 0.f; }
#pragma unroll
                for (int d0 = 0; d0 < 8; ++d0) { const int cb = (d0 * 16 + hi * 8) * 2;
                    const bf16x8 k0 = *(const LAS bf16x8*)(L + KL + bo + KSWZ(r32, cb));
                    const bf16x8 k1 = *(const LAS bf16x8*)(L + KL + bo + KSWZ(32 + r32, cb));
                    p0 = mfma32(k0, qr[d0], p0); p1 = mfma32(k1, qr[d0], p1);
                    if ((d0 & 3) == 3) __builtin_amdgcn_sched_barrier(0); }
                if (delta >= 3) { const float bc = *(LAS float*)(L + BL + 256 * 4);
#pragma unroll
                    for (int r = 0; r < 16; ++r) { p0[r] = fmaf(p0[r], C, bc); p1[r] = fmaf(p1[r], C, bc); }
                } else { const int base = qrow + 64 * delta + 128 - 4 * hi;
#pragma unroll
                    for (int r = 0; r < 16; ++r) { int i0 = base - ((r & 3) + 8 * (r >> 2)); int i1 = i0 - 32; i0 = i0 > 256 ? 256 : i0; i1 = i1 > 256 ? 256 : i1;
                        p0[r] = fmaf(p0[r], C, *(LAS float*)(L + BL + i0 * 4)); p1[r] = fmaf(p1[r], C, *(LAS float*)(L + BL + i1 * 4)); }
                }
                float pmax = p0[0];
#pragma unroll
                for (int r = 1; r < 16; ++r) pmax = fmaxf(pmax, p0[r]);
#pragma unroll
                for (int r = 0; r < 16; ++r) pmax = fmaxf(pmax, p1[r]);
                { auto rr = __builtin_amdgcn_permlane32_swap(__float_as_uint(pmax), __float_as_uint(pmax), false, false); pmax = fmaxf(__uint_as_float(rr[0]), __uint_as_float(rr[1])); }
                const float mn = fmaxf(m_reg, pmax), alpha = __builtin_amdgcn_exp2f(m_reg - mn); m_reg = mn;
                float ps = 0.f;
#pragma unroll
                for (int r = 0; r < 16; ++r) { p0[r] = __builtin_amdgcn_exp2f(p0[r] - mn); p1[r] = __builtin_amdgcn_exp2f(p1[r] - mn); ps += p0[r] + p1[r]; }
                { auto rr = __builtin_amdgcn_permlane32_swap(__float_as_uint(ps), __float_as_uint(ps), false, false); ps = __uint_as_float(rr[0]) + __uint_as_float(rr[1]); }
                l_reg = l_reg * alpha + ps;
                if (__any(alpha != 1.0f)) {
                if (hi == 0) al_l[r32] = alpha;
                LDS_WAIT();
#pragma unroll
                for (int r = 0; r < 16; ++r) { const float a = al_l[crow(r, hi)];
#pragma unroll
                    for (int d = 0; d < 4; ++d) o[d][r] *= a; } }
                bf16x8 pa[4];
#define PK4(PP, BASE, OUT) do { unsigned a0 = cvt_pk_bf16(PP[BASE + 0], PP[BASE + 1]), a1 = cvt_pk_bf16(PP[BASE + 2], PP[BASE + 3]);   \
                    unsigned b0 = cvt_pk_bf16(PP[BASE + 4], PP[BASE + 5]), b1 = cvt_pk_bf16(PP[BASE + 6], PP[BASE + 7]);                          \
                    auto r0 = __builtin_amdgcn_permlane32_swap(a0, b0, false, false); auto r1 = __builtin_amdgcn_permlane32_swap(a1, b1, false, false); \
                    u32x4 ww = {r0[0], r1[0], r0[1], r1[1]}; OUT = __builtin_bit_cast(bf16x8, ww); } while (0)
                PK4(p0, 0, pa[0]); PK4(p0, 8, pa[1]); PK4(p1, 0, pa[2]); PK4(p1, 8, pa[3]);
#undef PK4
#pragma unroll
                for (int d0 = 0; d0 < 4; ++d0) {
#pragma unroll
                    for (int ks = 0; ks < 4; ++ks) { const s16x4 lo = lds_tr(L + bo + vb + d0 * 512 + ks * 4096); const s16x4 hh = lds_tr(L + bo + vb + d0 * 512 + ks * 4096 + 2048);
                        o[d0] = mfma32(pa[ks], CAT8(lo, hh), o[d0]); }
                    __builtin_amdgcn_sched_barrier(0); }
            }
        }
#undef ASLOAD
        if (hi == 0) li_l[r32] = l_reg;
        LDS_WAIT();
        unsigned char* Ow = P.AO8 + (tq0 + 32 * w) * DM + h * AD;
        const unsigned eo = (unsigned)(4 * hi * DM + r32);
#pragma unroll
        for (int r = 0; r < 16; ++r) { const int orow = crow(r, hi); const float rl = __builtin_amdgcn_rcpf(li_l[orow]);
            unsigned char* Or = Ow + (size_t)((r & 3) + 8 * (r >> 2)) * DM; const float rs = rl * H8_SCALE;
#pragma unroll
            for (int d0 = 0; d0 < 4; ++d0) Or[eo + d0 * 32] = (unsigned char)(__builtin_amdgcn_cvt_pk_fp8_f32(__builtin_amdgcn_fmed3f(o[d0][r] * rs, -448.f, 448.f), 0.f, 0, false) & 0xff);
            if ((r & 3) == 3) __builtin_amdgcn_sched_barrier(0); }
    }
}

__device__ __forceinline__ void router_phase(const Frame& F, const Ptrs& P) {
    LAS float* WR = (LAS float*)F.lds;
    LAS unsigned* RI = (LAS unsigned*)(F.lds + 65536);
    LAS unsigned* EC = (LAS unsigned*)(F.lds + 65536 + 2048);
    for (int i = F.tid; i < DM * NE / 4; i += NWAVES * 64) ((LAS f32x4*)WR)[i] = ((const GAS f32x4*)P.router)[i];
    const int gw = F.vcu * NWAVES + F.wave, NGW = F.G * NWAVES;
    const float* gain = P.ln_ffn + DM;
    f32x4 gvr[8];
#pragma unroll
    for (int j = 0; j < 8; ++j) gvr[j] = *((const GAS f32x4*)gain + F.lane + 64 * j);
    constexpr int RB = 4;
    for (int row0 = gw; row0 < T; row0 += RB * NGW) {
        if (F.tid < 16) EC[F.tid] = 0u;
        __syncthreads();
        unsigned rowpk[RB][8];
#pragma unroll
        for (int it = 0; it < RB; ++it) { const int row = row0 + it * NGW; const bool live = row < T; const int rr_ = live ? row : row0;
            const GAS u32x2* xr = (const GAS u32x2*)(P.X3 + (size_t)rr_ * DM) + F.lane;
            f32x4 v[8]; float s = 0.f;
#pragma unroll
            for (int j = 0; j < 8; ++j) { const u32x2 a = xr[64 * j]; v[j] = (f32x4){bf_lo(a.x), bf_hi(a.x), bf_lo(a.y), bf_hi(a.y)}; s += (v[j].x * v[j].x + v[j].y * v[j].y) + (v[j].z * v[j].z + v[j].w * v[j].w); }
            const float rstd = 1.0f / sqrtf(wave_sum(s) * (1.0f / DM) + EPS);
            float lg[8];
            int lz = F.lane; asm volatile("" : "+v"(lz));
#pragma unroll
            for (int e = 0; e < 8; ++e) lg[e] = 0.f;
#pragma unroll
            for (int j = 0; j < 8; ++j) { const f32x4 hn = v[j] * rstd * gvr[j];
                rowpk[it][j] = I8_MOE ? pk4_i8(hn.x, hn.y, hn.z, hn.w, HI8_SCALE) : pk4_fp8(hn.x, hn.y, hn.z, hn.w, H8_SCALE);
#pragma unroll
                for (int i = 0; i < 4; ++i) { const LAS f32x4* wp = (const LAS f32x4*)(WR + (4 * (lz + 64 * j) + i) * 8); const f32x4 w0 = wp[0], w1 = wp[1]; const float hv = hn[i];
                    lg[0] += hv * w0.x; lg[1] += hv * w0.y; lg[2] += hv * w0.z; lg[3] += hv * w0.w; lg[4] += hv * w1.x; lg[5] += hv * w1.y; lg[6] += hv * w1.z; lg[7] += hv * w1.w; } }
#pragma unroll
            for (int e = 0; e < 8; ++e) lg[e] = wave_sum(lg[e]);
            int i1 = 0; float v1 = lg[0];
#pragma unroll
            for (int e = 1; e < 8; ++e) if (lg[e] > v1) { v1 = lg[e]; i1 = e; }
            int i2 = -1; float v2 = -3.0e38f;
#pragma unroll
            for (int e = 0; e < 8; ++e) if (e != i1 && lg[e] > v2) { v2 = lg[e]; i2 = e; }
            if (F.lane == 0 && live) {
                const float g1 = 1.0f / (1.0f + __expf(v2 - v1)), g2 = 1.0f - g1;
                const unsigned r1 = __hip_atomic_fetch_add(EC + i1, 1u, __ATOMIC_RELAXED, __HIP_MEMORY_SCOPE_WORKGROUP);
                const unsigned r2 = __hip_atomic_fetch_add(EC + i2, 1u, __ATOMIC_RELAXED, __HIP_MEMORY_SCOPE_WORKGROUP);
                LAS unsigned* ri = RI + (F.wave * 8 + it) * 8;
                ri[0] = (unsigned)i1; ri[1] = r1; ri[2] = (unsigned)i2; ri[3] = r2; ri[4] = __float_as_uint(g1); ri[5] = __float_as_uint(g2);
            }
            asm volatile("" ::: "memory"); __builtin_amdgcn_sched_barrier(0);
        }
        __syncthreads();
        if (F.tid < 8) EC[8 + F.tid] = __hip_atomic_fetch_add(F.ctl + CW_CNT + 64 * F.tid, EC[F.tid], RLX_AGENT);
        __syncthreads();
#pragma unroll
        for (int it = 0; it < RB; ++it) { const int row = row0 + it * NGW;
            if (row < T) { const LAS unsigned* ri = RI + (F.wave * 8 + it) * 8;
                const unsigned i1 = ri[0], i2 = ri[2], p1 = EC[8 + i1] + ri[1], p2 = EC[8 + i2] + ri[3];
                GAS unsigned* d1 = (GAS unsigned*)(P.AGC + ((size_t)i1 * T + p1) * DM) + F.lane; GAS unsigned* d2 = (GAS unsigned*)(P.AGC + ((size_t)i2 * T + p2) * DM) + F.lane;
#pragma unroll
                for (int j = 0; j < 8; ++j) { d1[64 * j] = rowpk[it][j]; d2[64 * j] = rowpk[it][j]; }
                if (F.lane == 0) { u32x4 t4; t4.x = i1; t4.y = p1; t4.z = i2; t4.w = p2;
                    *(GAS u32x4*)(P.TOK + (size_t)row * 8) = t4;
                    u32x2 g2v; g2v.x = ri[4]; g2v.y = ri[5];
                    *(GAS u32x2*)(P.TOK + (size_t)row * 8 + 4) = g2v; } } }
        __syncthreads();
    }
}
__device__ __forceinline__ void moe_offsets(const Frame& F, int (&toff)[9], int (&cnt)[8]) {
    int acc = 0;
#pragma unroll
    for (int e = 0; e < 8; ++e) { cnt[e] = __builtin_amdgcn_readfirstlane((int)__hip_atomic_load(F.ctl + CW_CNT + 64 * e, RLX_AGENT)); toff[e] = acc; acc += (cnt[e] + 255) >> 8; }
    toff[8] = acc;
}
__device__ __forceinline__ void gather_phase(const Frame& F, const Ptrs& P) {
    int toff[9], cnt[8]; moe_offsets(F, toff, cnt);
    const int gw = F.vcu * NWAVES + F.wave, NGW = F.G * NWAVES, R = toff[8] * 256;
    for (int r = gw; r < R; r += NGW) {
        const int tile = r >> 8; int e = 0;
#pragma unroll
        for (int j = 1; j < 8; ++j) e += (tile >= toff[j]) ? 1 : 0;
        const int pos = r - toff[e] * 256;
        GAS u32x4* dst = (GAS u32x4*)(P.AG + (size_t)r * DM) + F.lane;
        if (pos < cnt[e]) { const int src = P.LIST[(size_t)e * T + pos]; const GAS u32x4* sp = (const GAS u32x4*)(P.H8 + (size_t)src * DM) + F.lane;
#pragma unroll
            for (int j = 0; j < 2; ++j) dst[64 * j] = sp[64 * j];
        } else {
#pragma unroll
            for (int j = 0; j < 2; ++j) dst[64 * j] = (u32x4){0u, 0u, 0u, 0u};
        }
    }
}
__device__ __forceinline__ void final_phase(const Frame& F, const Ptrs& P) {
    int toff[9], cnt[8]; moe_offsets(F, toff, cnt);
    pg8::MoeTailOrder TO; TO.init(toff[8], DM / 256, FE / 2, F.G, 0);
    const size_t split_row = (size_t)TO.nMf * 256; const int nparts = TO.S;
    const int gw = F.vcu * NWAVES + F.wave, NGW = F.G * NWAVES;
    for (int row = gw; row < T; row += NGW) {
        const u32x4 t4 = *(const GAS u32x4*)(P.TOK + (size_t)row * 8); const u32x2 gg = *(const GAS u32x2*)(P.TOK + (size_t)row * 8 + 4);
        int o1 = 0, o2 = 0;
#pragma unroll
        for (int e = 0; e < 8; ++e) { o1 = ((int)t4.x == e) ? toff[e] : o1; o2 = ((int)t4.z == e) ? toff[e] : o2; }
        const size_t r1 = (size_t)o1 * 256 + t4.y, r2 = (size_t)o2 * 256 + t4.w; const float g1 = __uint_as_float(gg.x), g2 = __uint_as_float(gg.y);
        const GAS u32x2* xr = (const GAS u32x2*)(P.X3 + (size_t)row * DM) + F.lane;
        const GAS u32x2* y1 = (const GAS u32x2*)(P.YB + r1 * DM) + F.lane; const GAS u32x2* y2 = (const GAS u32x2*)(P.YB + r2 * DM) + F.lane;
        f32x4 v[8]; float s = 0.f;
#pragma unroll
        for (int j = 0; j < 8; ++j) { const u32x2 a = y1[64 * j], b = y2[64 * j];
            const f32x4 ya = (f32x4){bf_lo(a.x), bf_hi(a.x), bf_lo(a.y), bf_hi(a.y)}, yb = (f32x4){bf_lo(b.x), bf_hi(b.x), bf_lo(b.y), bf_hi(b.y)};
            const u32x2 xa = xr[64 * j];
            v[j] = (f32x4){bf_lo(xa.x), bf_hi(xa.x), bf_lo(xa.y), bf_hi(xa.y)} + (ya * g1 + yb * g2); }
        if (nparts > 1 && (r1 >= split_row || r2 >= split_row)) {
            for (int p = 1; p < nparts; ++p) { const float h1 = (r1 >= split_row) ? g1 : 0.f, h2 = (r2 >= split_row) ? g2 : 0.f;
                const GAS u32x2* z1 = y1 + ((r1 >= split_row) ? (size_t)p * MOE_ROWS * DM / 4 : 0); const GAS u32x2* z2 = y2 + ((r2 >= split_row) ? (size_t)p * MOE_ROWS * DM / 4 : 0);
#pragma unroll
                for (int j = 0; j < 8; ++j) { const u32x2 a = z1[64 * j], b = z2[64 * j];
                    const f32x4 ya = (f32x4){bf_lo(a.x), bf_hi(a.x), bf_lo(a.y), bf_hi(a.y)}, yb = (f32x4){bf_lo(b.x), bf_hi(b.x), bf_lo(b.y), bf_hi(b.y)};
                    v[j] = v[j] + (ya * h1 + yb * h2); } } }
#pragma unroll
        for (int j = 0; j < 8; ++j) { s += (v[j].x * v[j].x + v[j].y * v[j].y) + (v[j].z * v[j].z + v[j].w * v[j].w); }
        const float rstd = 1.0f / sqrtf(wave_sum(s) * (1.0f / DM) + EPS);
        GAS f32x4* o = (GAS f32x4*)(P.out + (size_t)row * DM) + F.lane;
#pragma unroll
        for (int j = 0; j < 8; ++j) { const f32x4 gvv = *((const GAS f32x4*)P.ln_final + F.lane + 64 * j); o[64 * j] = v[j] * rstd * gvv; }
    }
}

constexpr int N_PHASES = 17;
struct Args { const float* in[14]; float* out; unsigned char* ws; int ph_lo, ph_hi; };
__global__ void __launch_bounds__(NWAVES * 64, 2) trunk_fwd(Args args) {
    extern __shared__ __attribute__((aligned(16))) unsigned char lds[];
#define PHASE_SETUP() Frame F; Ptrs P; { int t_ = wave0 * 64 + (int)__builtin_amdgcn_mbcnt_hi(~0u, __builtin_amdgcn_mbcnt_lo(~0u, 0u)); asm volatile("" : "+v"(t_)); \
    unsigned char* ws = args.ws; asm volatile("" : "+s"(ws)); \
    F.lds = (LAS unsigned char*)lds; F.tid = t_; F.lane = t_ & 63; F.wave = __builtin_amdgcn_readfirstlane(t_ >> 6); \
    F.G = gridDim.x; { const int bx = blockIdx.x; F.vcu = (F.G % 8 == 0) ? (bx % 8) * (F.G / 8) + bx / 8 : bx; } \
    F.ctl = (unsigned*)(ws + WS_CTL); \
    P.x = args.in[0]; P.ln_mix = args.in[1]; P.ln_ffn = args.in[2]; P.ln_final = args.in[3]; P.ret_w_in = args.in[4]; P.ret_w_out = args.in[5]; P.ffn_w_in = args.in[6]; P.ffn_w_out = args.in[7]; \
    P.att_w_in = args.in[8]; P.att_w_out = args.in[9]; P.rel_bias = args.in[10]; P.router = args.in[11]; P.moe_w_in = args.in[12]; P.moe_w_out = args.in[13]; P.out = args.out; \
    P.W_RIN = (bf16_t*)(ws + WS_W_RIN); P.W_ROUT = (bf16_t*)(ws + WS_W_ROUT); P.W_FIN = (bf16_t*)(ws + WS_W_FIN); P.W_FOUT = (bf16_t*)(ws + WS_W_FOUT); \
    P.W_AIN = (bf16_t*)(ws + WS_W_AIN); P.W_AOUT = (bf16_t*)(ws + WS_W_AOUT); P.W_MIN = ws + WS_W_MIN; P.W_MOUT = ws + WS_W_MOUT; \
    P.H = (bf16_t*)(ws + WS_H); P.PROJ = (bf16_t*)(ws + WS_A); P.ACT = (bf16_t*)(ws + WS_A); P.QKV = (bf16_t*)(ws + WS_A); P.ACT2 = ws + WS_A; P.H8 = ws + WS_H; \
    P.OB = (bf16_t*)(ws + WS_B); P.AO = (bf16_t*)(ws + WS_B); P.AO8 = ws + WS_B; P.AG = ws + WS_B; P.AGC = ws + WS_AGC; P.Y = (bf16_t*)(ws + WS_Y); \
    P.X1 = (bf16_t*)(ws + WS_X1); P.X2 = (bf16_t*)(ws + WS_X2); P.X3 = (bf16_t*)(ws + WS_X3); P.YB = (bf16_t*)(ws + WS_YB); P.SSP = (float*)(ws + WS_SSP); \
    P.LIST = (int*)(ws + WS_LIST); P.TOK = (unsigned*)(ws + WS_TOK); }
    LAS unsigned char* const lds3 = (LAS unsigned char*)lds;
    const int wave0 = __builtin_amdgcn_readfirstlane((int)threadIdx.x >> 6);
    unsigned* const ctl0 = (unsigned*)(args.ws + WS_CTL);
    for (int u = threadIdx.x; u < (LDS_BYTES - LDSCTL_OFF) / 4; u += NWAVES * 64) ((LAS unsigned*)(lds3 + LDSCTL_OFF))[u] = 0u;
    __syncthreads();
    volatile LAS unsigned* MISC = (volatile LAS unsigned*)(lds3 + MISC_OFF);
    XcdBarrier bar; bar.bar = ctl0 + CW_BAR; bar.x = 0; bar.st = nullptr;
    if (!MK_PER_PHASE) bar = xcd_barrier_post(ctl0 + CW_BAR, MISC + 8);
    const int lo = args.ph_lo, hi = args.ph_hi;
#ifndef PH_MASK
#define PH_MASK 0x1ffff
#endif
#define IN(k) (((PH_MASK >> (k)) & 1) && lo <= (k) && (k) < hi)
#define SEAM(k) do { if (IN(k) && IN((k) + 1)) xcd_barrier(bar); } while (0)

    if (IN(0)) { PHASE_SETUP(); LAS unsigned char* ring = F.lds; (void)ring; p0_prologue(F, P); if (DUP_MASK & 1) p0_prologue(F, P); } SEAM(0);
#if DBG_STAGE >= 1
    if (IN(1)) { PHASE_SETUP(); LAS unsigned char* ring = F.lds; (void)ring;
#if I8_RIN
        pg8::Gemm g{(const bf16_t*)P.H8, P.W_RIN, T, NRET, DM / 2, 0u, 0u, 0u}; pg8::StaticOrder S; S.init(T, NRET, DM / 2, F.G, (int)blockIdx.x); pg8::EpiRetInT<true> E{P.PROJ, NRET, I8_DESCALE};
        pg8::gemm_phase<pg8::EpiRetInT<true>, pg8::StaticOrder, true, true, false, true>(ring, F.tid, g, S, E);
#else
        pg8::Gemm g{P.H, P.W_RIN, T, NRET, DM, 0u, 0u, 0u}; pg8::StaticOrder S; S.init(T, NRET, DM, F.G, (int)blockIdx.x); pg8::EpiRetIn E{P.PROJ, NRET, 0.f};
        pg8::gemm_phase<pg8::EpiRetIn, pg8::StaticOrder, true, true>(ring, F.tid, g, S, E);
#endif
    } SEAM(1);
    if (IN(2)) { PHASE_SETUP(); LAS unsigned char* ring = F.lds; (void)ring; retention_phase(F, P); if (DUP_MASK & 4) retention_phase(F, P); } SEAM(2);
    if (IN(3)) { PHASE_SETUP(); LAS unsigned char* ring = F.lds; (void)ring; gate_phase(F, P); if (DUP_MASK & 8) gate_phase(F, P); } SEAM(3);
    if (IN(4)) { PHASE_SETUP(); LAS unsigned char* ring = F.lds; (void)ring; pg8::Gemm g{P.Y, P.W_ROUT, T, DM, RHV, 0u, 0u, 0u}; pg8::StaticOrder S; S.init(T, DM, RHV, F.G, (int)blockIdx.x); pg8::EpiResB<false> E{P.x, P.X1, DM};
        pg8::gemm_phase<pg8::EpiResB<false>, pg8::StaticOrder, true, true>(ring, F.tid, g, S, E); } SEAM(4);
#endif
#if DBG_STAGE >= 2
    if (IN(5)) { PHASE_SETUP(); LAS unsigned char* ring = F.lds; (void)ring; norm_rows_i8b(F, P.X1, P.ln_ffn, P.H8); if (DUP_MASK & 32) norm_rows_i8b(F, P.X1, P.ln_ffn, P.H8); } SEAM(5);
    if (IN(6)) { PHASE_SETUP(); LAS unsigned char* ring = F.lds; (void)ring; pg8::Gemm g{(const bf16_t*)P.H8, P.W_FIN, T, 2 * FF, DM / 2, 0u, 0u, 0u}; pg8::StaticOrder S; S.init(T, 2 * FF, DM / 2, F.G, (int)blockIdx.x);
#if F8_FOUT
        pg8::EpiSwiglu8T<true> E{(unsigned char*)P.ACT, FF, A2_SCALE, I8_DESCALE};
        pg8::gemm_phase<pg8::EpiSwiglu8T<true>, pg8::StaticOrder, true, true, false, true>(ring, F.tid, g, S, E); } SEAM(6);
#else
        pg8::EpiSwigluI E{P.ACT, FF, I8_DESCALE};
        pg8::gemm_phase<pg8::EpiSwigluI, pg8::StaticOrder, true, true, false, true>(ring, F.tid, g, S, E); } SEAM(6);
#endif
#if F8_FOUT
    if (IN(7)) { PHASE_SETUP(); LAS unsigned char* ring = F.lds; (void)ring; pg8::Gemm g{P.ACT, P.W_FOUT, T, DM, FF / 2, SB_W2, SB_A2, SB_W2}; pg8::StaticOrder S; S.init(T, DM, FF / 2, F.G, (int)blockIdx.x); pg8::EpiResB<true> E{P.X1, P.X2, DM};
        pg8::gemm_phase<pg8::EpiResB<true>, pg8::StaticOrder, true, true, true>(ring, F.tid, g, S, E); } SEAM(7);
#else
    if (IN(7)) { PHASE_SETUP(); LAS unsigned char* ring = F.lds; (void)ring; pg8::Gemm g{P.ACT, P.W_FOUT, T, DM, FF, 0u, 0u, 0u}; pg8::StaticOrder S; S.init(T, DM, FF, F.G, (int)blockIdx.x); pg8::EpiResB<true> E{P.X1, P.X2, DM};
        pg8::gemm_phase<pg8::EpiResB<true>, pg8::StaticOrder, true, true>(ring, F.tid, g, S, E); } SEAM(7);
#endif
#endif
#if DBG_STAGE >= 3
    if (IN(8)) { PHASE_SETUP(); LAS unsigned char* ring = F.lds; (void)ring; norm_rows_i8b(F, P.X2, P.ln_mix + DM, P.H8); if (DUP_MASK & 256) norm_rows_i8b(F, P.X2, P.ln_mix + DM, P.H8); } SEAM(8);
    if (IN(9)) { PHASE_SETUP(); LAS unsigned char* ring = F.lds; (void)ring; pg8::Gemm g{(const bf16_t*)P.H8, P.W_AIN, T, NATT, DM / 2, SB_W1, SB_H8, SB_W1}; pg8::StaticOrder S; S.init(T, NATT, DM / 2, F.G, (int)blockIdx.x);
#if I8_QKV
        pg8::EpiBf16T<true> E{P.QKV, NATT, 0, I8_DESCALE};
        pg8::gemm_phase<pg8::EpiBf16T<true>, pg8::StaticOrder, true, true, false, true>(ring, F.tid, g, S, E);
#else
        pg8::EpiBf16 E{P.QKV, NATT, 0, 0.f};
        pg8::gemm_phase<pg8::EpiBf16, pg8::StaticOrder, true, true, true>(ring, F.tid, g, S, E);
#endif
    } SEAM(9);
    if (IN(10)) { PHASE_SETUP(); LAS unsigned char* ring = F.lds; (void)ring; attention_phase(F, P); if (DUP_MASK & 1024) attention_phase(F, P); } SEAM(10);
    if (IN(11)) { PHASE_SETUP(); LAS unsigned char* ring = F.lds; (void)ring; pg8::Gemm g{(const bf16_t*)P.AO8, P.W_AOUT, T, DM, DM / 2, SB_W1, SB_H8, SB_W1}; pg8::StaticOrder S; S.init(T, DM, DM / 2, F.G, (int)blockIdx.x); pg8::EpiResB<true> E{P.X2, P.X3, DM};
        pg8::gemm_phase<pg8::EpiResB<true>, pg8::StaticOrder, true, true, true>(ring, F.tid, g, S, E); } SEAM(11);
#endif
#if DBG_STAGE >= 100
    if (IN(12)) { PHASE_SETUP(); LAS unsigned char* ring = F.lds; (void)ring; router_phase(F, P); } SEAM(12);
    if (IN(13)) {   }
    if (IN(14)) { PHASE_SETUP(); LAS unsigned char* ring = F.lds; (void)ring; int toff[9], cnt[8]; moe_offsets(F, toff, cnt);
        pg8::MoeOrder S; S.nM = toff[8]; S.nN = 2 * FE / 256; S.nwg = S.nM * S.nN; S.G = F.G; S.c = (int)blockIdx.x; S.nt0 = (DM / 2) / 64; S.aseg = T; S.estride = (unsigned)(2 * FE * DM);
#pragma unroll
        for (int e = 0; e < 9; ++e) S.toff[e] = toff[e];
        pg8::Gemm g{(const bf16_t*)P.AGC, (const bf16_t*)P.W_MIN, toff[8] * 256, 2 * FE, DM / 2, SB_W1, SB_H8, SB_W1U};
#if I8_MOE
        pg8::EpiSwiglu8T<true> E{P.ACT2, FE, A2_SCALE, I8_DESCALE};
        pg8::gemm_phase<pg8::EpiSwiglu8T<true>, pg8::MoeOrder, true, true, false, true>(ring, F.tid, g, S, E);
#else
        pg8::EpiSwiglu8 E{P.ACT2, FE, 1.0f, 0.f};
        pg8::gemm_phase<pg8::EpiSwiglu8, pg8::MoeOrder, true, true, true>(ring, F.tid, g, S, E);
#endif
    } SEAM(14);
    if (IN(15)) { PHASE_SETUP(); LAS unsigned char* ring = F.lds; (void)ring; int toff[9], cnt[8]; moe_offsets(F, toff, cnt);
        pg8::MoeTailOrder S; S.init(toff[8], DM / 256, FE / 2, F.G, (int)blockIdx.x); S.estride = (unsigned)(DM * FE);
#pragma unroll
        for (int e = 0; e < 9; ++e) S.toff[e] = toff[e];
        pg8::Gemm g{(const bf16_t*)P.ACT2, (const bf16_t*)P.W_MOUT, toff[8] * 256, DM, FE / 2, SB_W2, SB_A2, SB_W2}; pg8::EpiBf16 E{P.YB, DM, (size_t)MOE_ROWS * DM, 0.f};
        pg8::gemm_phase<pg8::EpiBf16, pg8::MoeTailOrder, true, true, true>(ring, F.tid, g, S, E); } SEAM(15);
    if (IN(16)) { PHASE_SETUP(); LAS unsigned char* ring = F.lds; (void)ring; final_phase(F, P); if (DUP_MASK & 65536) final_phase(F, P); }
#else
    if (IN(16)) { PHASE_SETUP(); LAS unsigned char* ring = F.lds; (void)ring; norm_rows_f32(F, P.x, P.ln_final, P.out); }
#endif
#undef IN
#undef SEAM
}

extern "C" void kernel_launch(void* const* d_in, const int* in_sizes, int n_in, void* d_out, int out_size, void* d_ws, size_t ws_size, hipStream_t stream) {
    static int grid = 0;
    if (grid == 0) {
        if (n_in != 14 || in_sizes[0] != T * DM || out_size != T * DM || ws_size < WS_END) { fprintf(stderr, "kernel_launch: shape mismatch (n_in %d in0 %d out %d ws %zu, need ws >= %zu)\n", n_in, n_in > 0 ? in_sizes[0] : -1, out_size, ws_size, (size_t)WS_END); grid = -1; return; }
        int dev = 0, cus = 0, per_cu = 0;
        if (hipGetDevice(&dev) != hipSuccess || hipDeviceGetAttribute(&cus, hipDeviceAttributeMultiprocessorCount, dev) != hipSuccess) { fprintf(stderr, "kernel_launch: device query failed\n"); grid = -1; return; }
        if (hipFuncSetAttribute((const void*)trunk_fwd, hipFuncAttributeMaxDynamicSharedMemorySize, LDS_BYTES) != hipSuccess) { fprintf(stderr, "kernel_launch: hipFuncSetAttribute failed\n"); grid = -1; return; }
        if (hipOccupancyMaxActiveBlocksPerMultiprocessor(&per_cu, (const void*)trunk_fwd, NWAVES * 64, LDS_BYTES) != hipSuccess || per_cu < 1)
            fprintf(stderr, "kernel_launch: note: occupancy query reports %d workgroups per CU\n", per_cu);
        (void)hipGetLastError();
        grid = cus;
    }
    if (grid < 0) return;
    if (hipMemsetAsync((char*)d_ws + WS_CTL, 0, CTL_ZERO_BYTES, stream) != hipSuccess) { fprintf(stderr, "kernel_launch: memset failed\n"); return; }
    Args a{};
    for (int i = 0; i < 14; ++i) a.in[i] = (const float*)d_in[i];
    a.out = (float*)d_out; a.ws = (unsigned char*)d_ws;
#if MK_PER_PHASE
    for (int ph = 0; ph < N_PHASES; ++ph) { a.ph_lo = ph; a.ph_hi = ph + 1; hipLaunchKernelGGL(trunk_fwd, dim3(grid), dim3(NWAVES * 64), LDS_BYTES, stream, a); }
#else
    a.ph_lo = 0; a.ph_hi = N_PHASES;
    hipLaunchKernelGGL(trunk_fwd, dim3(grid), dim3(NWAVES * 64), LDS_BYTES, stream, a);
#endif
    const hipError_t le = hipPeekAtLastError();
    if (le != hipSuccess) fprintf(stderr, "kernel_launch: launch failed: %s\n", hipGetErrorName(le));
}
```
